# Optimizing an MI355X kernel written in HIP

```python
import math
import jax, jax.numpy as jnp
from jax import lax
import numpy as np

D_MODEL = 1024
BATCH = 2
SEQ = 16384
DEPTH = 2

N_MIXERS = 4
GROUP_W = D_MODEL // N_MIXERS
D_MIX = N_MIXERS * GROUP_W

MLA_HEADS = 4
MLA_V_DIM = GROUP_W // MLA_HEADS
MLA_NOPE_DIM = MLA_V_DIM // 2
MLA_ROPE_DIM = MLA_V_DIM // 4
MLA_Q_LORA = GROUP_W
MLA_KV_LORA = GROUP_W // 2
ATTN_BLOCK = 128

SSD_HEADS = 4
SSD_HEAD_DIM = GROUP_W // SSD_HEADS
SSD_INNER = SSD_HEADS * SSD_HEAD_DIM
SSD_GROUPS = 2
SSD_STATE = 128
SSD_XBC = SSD_INNER + 2 * SSD_GROUPS * SSD_STATE
SSD_CONV = 4
SSD_CHUNK = 128

RET_HEADS = 4
RET_HEAD_DIM = GROUP_W // RET_HEADS
RET_CHUNK = 128

LRU_WIDTH = GROUP_W
LRU_BLOCKS = 4
LRU_BLOCK_DIM = LRU_WIDTH // LRU_BLOCKS
LRU_CONV = 4
LRU_C = 8.0

D_FF = ((8 * D_MODEL + 3 * 256 - 1) // (3 * 256)) * 256

ROPE_THETA = 10000.0
NORM_EPS = 1e-5
ALPHA = (2.0 * DEPTH) ** 0.25
BETA = (8.0 * DEPTH) ** -0.25

N_IN = (MLA_Q_LORA + MLA_KV_LORA + MLA_ROPE_DIM + SSD_INNER + SSD_XBC + SSD_HEADS
        + 4 * GROUP_W + 2 * LRU_WIDTH)

F32 = jnp.float32

kernel_name = "hybrid_mla_ssd_retention_rglru_block"


def _in_splits():
    widths = [MLA_Q_LORA, MLA_KV_LORA, MLA_ROPE_DIM,
              SSD_INNER, SSD_XBC, SSD_HEADS,
              GROUP_W, GROUP_W, GROUP_W, GROUP_W,
              LRU_WIDTH, LRU_WIDTH]
    return [int(v) for v in np.cumsum(widths)[:-1]]


def layernorm(x, g, b):
    xf = x.astype(F32)
    mu = jnp.mean(xf, -1, keepdims=True)
    var = jnp.mean(jnp.square(xf - mu), -1, keepdims=True)
    return ((xf - mu) * lax.rsqrt(var + NORM_EPS) * g + b).astype(x.dtype)


def rmsnorm(x, g):
    xf = x.astype(F32)
    return (xf * lax.rsqrt(jnp.mean(jnp.square(xf), -1, keepdims=True) + NORM_EPS) * g).astype(x.dtype)


def rope(x, positions):
    d = x.shape[-1]
    inv = ROPE_THETA ** (-jnp.arange(0, d, 2, dtype=F32) / d)
    ang = positions.astype(F32)[..., None] * inv
    cos = jnp.cos(ang)[:, :, None, :].astype(x.dtype)
    sin = jnp.sin(ang)[:, :, None, :].astype(x.dtype)
    x1, x2 = x[..., : d // 2], x[..., d // 2:]
    return jnp.concatenate([x1 * cos - x2 * sin, x1 * sin + x2 * cos], -1)


def causal_dwconv(x, w, b):
    k, c = w.shape
    y = lax.conv_general_dilated(x, w[:, None, :], window_strides=(1,), padding=[(k - 1, 0)],
                                 dimension_numbers=("NWC", "WIO", "NWC"), feature_group_count=c)
    return y + b


def mla_mixer(cq, ckv, kr, positions, g_q, w_uq, g_kv, w_ukv):
    b, s, _ = cq.shape
    dqk = MLA_NOPE_DIM + MLA_ROPE_DIM
    q = (rmsnorm(cq, g_q) @ w_uq).reshape(b, s, MLA_HEADS, dqk)
    q = jnp.concatenate([q[..., :MLA_NOPE_DIM], rope(q[..., MLA_NOPE_DIM:], positions)], -1)
    kv = (rmsnorm(ckv, g_kv) @ w_ukv).reshape(b, s, MLA_HEADS, MLA_NOPE_DIM + MLA_V_DIM)
    k_rope = jnp.broadcast_to(rope(kr[:, :, None, :], positions), (b, s, MLA_HEADS, MLA_ROPE_DIM))
    k = jnp.concatenate([kv[..., :MLA_NOPE_DIM], k_rope], -1)
    v = kv[..., MLA_NOPE_DIM:]
    scale = dqk ** -0.5
    nb = s // ATTN_BLOCK
    q_blocks = q.reshape(b, nb, ATTN_BLOCK, MLA_HEADS, dqk).transpose(1, 0, 2, 3, 4)
    k_pos = jnp.arange(s)

    def block(args):
        qb, i = args
        q_pos = i * ATTN_BLOCK + jnp.arange(ATTN_BLOCK)
        sc = jnp.einsum("bqhd,bkhd->bhqk", qb, k, preferred_element_type=F32) * scale
        sc = jnp.where(k_pos[None, :] <= q_pos[:, None], sc, -jnp.inf)
        p = jax.nn.softmax(sc, axis=-1).astype(v.dtype)
        return jnp.einsum("bhqk,bkhd->bqhd", p, v)

    o = lax.map(block, (q_blocks, jnp.arange(nb)))
    return o.transpose(1, 0, 2, 3, 4).reshape(b, s, MLA_HEADS * MLA_V_DIM)


def ssd_chunked(x, a, bm, cm):
    b, s, h, p = x.shape
    n = bm.shape[-1]
    c, l = s // SSD_CHUNK, SSD_CHUNK
    x = x.reshape(b, c, l, h, p)
    bm = bm.reshape(b, c, l, h, n)
    cm = cm.reshape(b, c, l, h, n)
    a_cs = jnp.cumsum(a.reshape(b, c, l, h).transpose(0, 3, 1, 2), -1)
    tril = jnp.tril(jnp.ones((l, l), dtype=bool))
    seg = jnp.exp(jnp.where(tril, a_cs[..., :, None] - a_cs[..., None, :], -jnp.inf))
    y_diag = jnp.einsum("bclhn,bcshn,bhcls,bcshp->bclhp", cm, bm, seg, x)
    decay_to_end = jnp.exp(a_cs[..., -1:] - a_cs)
    chunk_states = jnp.einsum("bclhn,bhcl,bclhp->bchpn", bm, decay_to_end, x)
    chunk_decay = jnp.exp(a_cs[..., -1])

    def step(state, inp):
        st, dec = inp
        return state * dec[..., None, None] + st, state

    _, prev = lax.scan(step, jnp.zeros((b, h, p, n), F32),
                       (chunk_states.transpose(1, 0, 2, 3, 4), chunk_decay.transpose(2, 0, 1)))
    prev = prev.transpose(1, 0, 2, 3, 4)
    y_off = jnp.einsum("bclhn,bchpn,bhcl->bclhp", cm, prev, jnp.exp(a_cs))
    return (y_diag + y_off).reshape(b, s, h, p)


def ssd_mixer(z, xbc, dt_raw, conv_w, conv_b, dt_bias, a_log, d_skip, norm_g):
    b, s, _ = z.shape
    xbc = jax.nn.silu(causal_dwconv(xbc, conv_w, conv_b)).astype(F32)
    gn = SSD_GROUPS * SSD_STATE
    rep = SSD_HEADS // SSD_GROUPS
    xs = xbc[..., :SSD_INNER].reshape(b, s, SSD_HEADS, SSD_HEAD_DIM)
    bm = jnp.repeat(xbc[..., SSD_INNER:SSD_INNER + gn].reshape(b, s, SSD_GROUPS, SSD_STATE), rep, axis=2)
    cm = jnp.repeat(xbc[..., SSD_INNER + gn:].reshape(b, s, SSD_GROUPS, SSD_STATE), rep, axis=2)
    dt = jax.nn.softplus(dt_raw.astype(F32) + dt_bias.astype(F32))
    a = -jnp.exp(a_log.astype(F32))
    y = ssd_chunked(xs * dt[..., None], dt * a, bm, cm) + xs * d_skip.astype(F32)[:, None]
    y = y.reshape(b, s, SSD_INNER) * jax.nn.silu(z.astype(F32))
    return rmsnorm(y, norm_g.astype(F32)).astype(z.dtype)


def retention_mixer(q, k, v, g, positions, gn_g, gn_b):
    b, s, _ = q.shape
    H, d, l = RET_HEADS, RET_HEAD_DIM, RET_CHUNK
    c = s // l
    q = rope(q.reshape(b, s, H, d), positions).astype(F32)
    k = rope(k.reshape(b, s, H, d), positions).astype(F32) * (d ** -0.5)
    v = v.reshape(b, s, H, d).astype(F32)
    log_gamma = jnp.log1p(-(2.0 ** (-5.0 - jnp.arange(H, dtype=F32))))
    idx = jnp.arange(l, dtype=F32)
    rel = idx[:, None] - idx[None, :]
    intra = jnp.where(rel >= 0, jnp.exp(log_gamma[:, None, None] * jnp.maximum(rel, 0.0)), 0.0)
    q_dec = jnp.exp(log_gamma[None, :] * (idx[:, None] + 1.0))[None, :, :, None]
    k_dec = jnp.exp(log_gamma[None, :] * (l - 1.0 - idx[:, None]))[None, :, :, None]
    c_dec = jnp.exp(log_gamma * l)[None, :, None, None]

    def to_chunks(t):
        return t.reshape(b, c, l, H, d).transpose(1, 0, 2, 3, 4)

    def step(state, inp):
        qc, kc, vc = inp
        sc = jnp.einsum("bihd,bjhd->bhij", qc, kc) * intra
        o = jnp.einsum("bhij,bjhe->bihe", sc, vc) + jnp.einsum("bihd,bhde->bihe", qc, state) * q_dec
        state = state * c_dec + jnp.einsum("bjhd,bjhe->bhde", kc * k_dec, vc)
        return state, o

    _, o = lax.scan(step, jnp.zeros((b, H, d, d), F32), (to_chunks(q), to_chunks(k), to_chunks(v)))
    o = o.transpose(1, 0, 2, 3, 4).reshape(b, s, H, d)
    mu = jnp.mean(o, -1, keepdims=True)
    var = jnp.mean(jnp.square(o - mu), -1, keepdims=True)
    o = ((o - mu) * lax.rsqrt(var + NORM_EPS)).reshape(b, s, H * d) * gn_g + gn_b
    return (jax.nn.silu(g.astype(F32)) * o).astype(g.dtype)


def _linear_recurrence_combine(left, right):
    a1, b1 = left
    a2, b2 = right
    return a1 * a2, a2 * b1 + b2


def rglru_mixer(xb, gb, conv_w, conv_b, w_a, b_a, w_x, b_x, a_param):
    b, s, _ = xb.shape
    u = causal_dwconv(xb, conv_w, conv_b).astype(F32)
    ub = u.reshape(b, s, LRU_BLOCKS, LRU_BLOCK_DIM)
    r = jax.nn.sigmoid(jnp.einsum("bsgi,gij->bsgj", ub, w_a.astype(F32)).reshape(b, s, LRU_WIDTH) + b_a)
    i = jax.nn.sigmoid(jnp.einsum("bsgi,gij->bsgj", ub, w_x.astype(F32)).reshape(b, s, LRU_WIDTH) + b_x)
    log_a = -LRU_C * r * jax.nn.softplus(-a_param.astype(F32))
    a = jnp.exp(log_a)
    inp = jnp.sqrt(-jnp.expm1(2.0 * log_a)) * (i * u)
    _, h = lax.associative_scan(_linear_recurrence_combine, (a, inp), axis=1)
    return (h * jax.nn.gelu(gb.astype(F32))).astype(xb.dtype)


def swiglu(x, w_in, w_out):
    gu = x @ w_in
    return (jax.nn.silu(gu[..., :D_FF]) * gu[..., D_FF:]) @ w_out


def setup_inputs(seed: int = 0) -> dict:
    key = jax.random.key(seed)
    ks = iter(jax.random.split(key, 40))
    L = DEPTH

    def nrm(shape, scale):
        return jax.random.normal(next(ks), shape, F32) * scale

    def gain(shape):
        return 1.0 + nrm(shape, 0.02)

    x = jax.random.normal(next(ks), (BATCH, SEQ, D_MODEL), F32)
    positions = jnp.broadcast_to(jnp.arange(SEQ, dtype=jnp.int32)[None, :], (BATCH, SEQ))
    w_in = nrm((L, D_MODEL, N_IN), D_MODEL ** -0.5)
    mla_g_q = gain((L, MLA_Q_LORA))
    mla_w_uq = nrm((L, MLA_Q_LORA, MLA_HEADS * (MLA_NOPE_DIM + MLA_ROPE_DIM)), MLA_Q_LORA ** -0.5)
    mla_g_kv = gain((L, MLA_KV_LORA))
    mla_w_ukv = nrm((L, MLA_KV_LORA, MLA_HEADS * (MLA_NOPE_DIM + MLA_V_DIM)), MLA_KV_LORA ** -0.5)
    ssd_conv_w = nrm((L, SSD_CONV, SSD_XBC), SSD_CONV ** -0.5)
    ssd_conv_b = nrm((L, SSD_XBC), 0.02)
    u = jax.random.uniform(next(ks), (L, SSD_HEADS), F32)
    dt0 = jnp.exp(u * (math.log(0.1) - math.log(0.001)) + math.log(0.001))
    ssd_dt_bias = dt0 + jnp.log(-jnp.expm1(-dt0))
    ssd_a_log = jnp.log(jax.random.uniform(next(ks), (L, SSD_HEADS), F32, 1.0, 16.0))
    ssd_d = gain((L, SSD_HEADS))
    ssd_norm_g = gain((L, SSD_INNER))
    ret_gn_g = gain((L, GROUP_W))
    ret_gn_b = nrm((L, GROUP_W), 0.02)
    lru_conv_w = nrm((L, LRU_CONV, LRU_WIDTH), LRU_CONV ** -0.5)
    lru_conv_b = nrm((L, LRU_WIDTH), 0.02)
    lru_w_a = nrm((L, LRU_BLOCKS, LRU_BLOCK_DIM, LRU_BLOCK_DIM), LRU_BLOCK_DIM ** -0.5)
    lru_b_a = nrm((L, LRU_WIDTH), 0.02)
    lru_w_x = nrm((L, LRU_BLOCKS, LRU_BLOCK_DIM, LRU_BLOCK_DIM), LRU_BLOCK_DIM ** -0.5)
    lru_b_x = nrm((L, LRU_WIDTH), 0.02)
    a_c = jax.random.uniform(next(ks), (L, LRU_WIDTH), F32, 0.9, 0.999)
    a_s = a_c ** (1.0 / LRU_C)
    lru_a_param = jnp.log(a_s) - jnp.log1p(-a_s)
    w_out = nrm((L, D_MIX, D_MODEL), BETA * D_MIX ** -0.5)
    ln1_g = gain((L, D_MODEL))
    ln1_b = nrm((L, D_MODEL), 0.02)
    w_ffn_in = nrm((L, D_MODEL, 2 * D_FF), D_MODEL ** -0.5)
    w_ffn_out = nrm((L, D_FF, D_MODEL), BETA * D_FF ** -0.5)
    ln2_g = gain((L, D_MODEL))
    ln2_b = nrm((L, D_MODEL), 0.02)
    return {"x": x, "positions": positions, "w_in": w_in,
            "mla_g_q": mla_g_q, "mla_w_uq": mla_w_uq, "mla_g_kv": mla_g_kv, "mla_w_ukv": mla_w_ukv,
            "ssd_conv_w": ssd_conv_w, "ssd_conv_b": ssd_conv_b, "ssd_dt_bias": ssd_dt_bias,
            "ssd_a_log": ssd_a_log, "ssd_d": ssd_d, "ssd_norm_g": ssd_norm_g,
            "ret_gn_g": ret_gn_g, "ret_gn_b": ret_gn_b,
            "lru_conv_w": lru_conv_w, "lru_conv_b": lru_conv_b, "lru_w_a": lru_w_a, "lru_b_a": lru_b_a,
            "lru_w_x": lru_w_x, "lru_b_x": lru_b_x, "lru_a_param": lru_a_param,
            "w_out": w_out, "ln1_g": ln1_g, "ln1_b": ln1_b,
            "w_ffn_in": w_ffn_in, "w_ffn_out": w_ffn_out, "ln2_g": ln2_g, "ln2_b": ln2_b}


def reference(x, positions, w_in, mla_g_q, mla_w_uq, mla_g_kv, mla_w_ukv,
              ssd_conv_w, ssd_conv_b, ssd_dt_bias, ssd_a_log, ssd_d, ssd_norm_g,
              ret_gn_g, ret_gn_b,
              lru_conv_w, lru_conv_b, lru_w_a, lru_b_a, lru_w_x, lru_b_x, lru_a_param,
              w_out, ln1_g, ln1_b, w_ffn_in, w_ffn_out, ln2_g, ln2_b):
    splits = _in_splits()
    for l in range(DEPTH):
        h = x @ w_in[l]
        cq, ckv, kr, z, xbc, dt_raw, rq, rk, rv, rg, lx, lg = jnp.split(h, splits, axis=-1)
        y_a = mla_mixer(cq, ckv, kr, positions, mla_g_q[l], mla_w_uq[l], mla_g_kv[l], mla_w_ukv[l])
        y_b = ssd_mixer(z, xbc, dt_raw, ssd_conv_w[l], ssd_conv_b[l], ssd_dt_bias[l], ssd_a_log[l],
                        ssd_d[l], ssd_norm_g[l])
        y_c = retention_mixer(rq, rk, rv, rg, positions, ret_gn_g[l], ret_gn_b[l])
        y_d = rglru_mixer(lx, lg, lru_conv_w[l], lru_conv_b[l], lru_w_a[l], lru_b_a[l],
                          lru_w_x[l], lru_b_x[l], lru_a_param[l])
        mix = jnp.concatenate([y_a, y_b, y_c, y_d], axis=-1) @ w_out[l]
        x = layernorm(ALPHA * x + mix, ln1_g[l], ln1_b[l])
        x = layernorm(ALPHA * x + swiglu(x, w_ffn_in[l], w_ffn_out[l]), ln2_g[l], ln2_b[l])
    return x
```

```cpp
#include <hip/hip_runtime.h>
#include <hip/hip_cooperative_groups.h>
#include <cstdio>
#include <cstdint>
__device__ __forceinline__ int ltid(int wv) { int l; asm volatile("v_mbcnt_lo_u32_b32 %0, -1, 0\n\tv_mbcnt_hi_u32_b32 %0, -1, %0" : "=v"(l)); asm volatile("" : "+s"(wv)); return (wv << 6) | l; }
__device__ __forceinline__ int lbid() { int b = blockIdx.x; asm volatile("" : "+s"(b)); return b; }
__device__ __forceinline__ int lgdim() { int g = gridDim.x; asm volatile("" : "+s"(g)); return g; }
namespace pg8 {
#define PG8_LAS __attribute__((address_space(3)))
typedef unsigned short bf16_t;
typedef short bf16x8 __attribute__((ext_vector_type(8)));
typedef float f32x4 __attribute__((ext_vector_type(4)));
typedef unsigned u32x4 __attribute__((ext_vector_type(4)));
constexpr int BM = 256, BK = 64, HALF = 128, HTB = HALF * BK * 2  , STAGE_BYTES = 8 * HTB, NXCD = 8, WGM = 8;

__host__ __device__ __forceinline__ int lds_byte(int r, int c) { const int st = (r >> 4) * 2 + (c >> 5), rr = r & 15, cc = c & 31, ob = rr * 64 + cc * 2; return st * 1024 + (ob ^ (((ob >> 9) & 1) << 5)); }
__host__ __device__ __forceinline__ void stage_rc(int b, int& R, int& C) { const int st = b / 1024, sb = b % 1024, swz = sb ^ (((sb >> 9) & 1) << 5); R = (st >> 1) * 16 + swz / 64; C = (st & 1) * 32 + (swz % 64) / 2; }
__host__ __device__ __forceinline__ int perm32(int rho) { const int n = rho >> 4, i = rho & 15; return 8 * (i >> 2) + 4 * n + (i & 3); }

struct Unit { int pm, pn; };
struct Gemm { const bf16_t* A; const bf16_t* Bt; int M, N, K, lda; };

struct StaticOrder {
    int nM, nN, nwg, G, c;
    __host__ __device__ void init(int M, int N, int G_, int c_) { nM = M / BM; nN = N / BM; nwg = nM * nN; G = G_; c = c_; }
    __host__ __device__ bool next(int i, Unit& u) const {
        const long L = (long)i * G + c; if (L >= nwg) return false;
        int wgid = (int)L; { const int q = nwg / NXCD, r = nwg % NXCD, xcd = wgid % NXCD, off = wgid / NXCD; wgid = (xcd < r ? xcd * (q + 1) : r * (q + 1) + (xcd - r) * q) + off; }
        const int nig = WGM * nN, gid = wgid / nig, fm = gid * WGM, gsz = (nM - fm) < WGM ? (nM - fm) : WGM;
        u.pm = fm + ((wgid % nig) % gsz); u.pn = (wgid % nig) / gsz; return true;
    }
    __device__ __forceinline__ void a_ready(const Unit&) const {}
    __device__ __forceinline__ void done(const Unit&) const {}
};

__device__ __forceinline__ unsigned cvt_pk_bf16(float lo, float hi) { unsigned r; asm volatile("v_cvt_pk_bf16_f32 %0, %1, %2" : "=v"(r) : "v"(lo), "v"(hi)); return r; }
typedef float f32x2 __attribute__((ext_vector_type(2)));
template <class Epi, class Sched, bool ALIGN_EPI = false, bool SP2 = false>
__device__ __forceinline__ void gemm_phase(PG8_LAS unsigned char* lds, const Gemm g, const Sched& S, const Epi& E, int wv) {
    const int tid = ltid(wv), wid = __builtin_amdgcn_readfirstlane(tid >> 6), lane = tid & 63, wr = wid >> 2, wc = wid & 3, fr = lane & 15, fq = lane >> 4;
    const int K = g.K, nt = K / BK;
    unsigned voffA[2], voffB[2];
#pragma unroll
    for (int i = 0; i < 2; ++i) { int R, C; stage_rc(tid * 16 + i * 8192, R, C); const int Rb = Epi::PERM ? ((R & ~31) + perm32(R & 31)) : R;
        voffA[i] = (unsigned)(R * g.lda + C) * 2u; voffB[i] = (unsigned)(Rb * K + C) * 2u; }
    const size_t kstep = (size_t)(BK * 2);
    const size_t hstepA = (size_t)HALF * g.lda * 2, hstepB = (size_t)HALF * K * 2;
    const size_t tstepA = 2 * hstepA, tstepB = 2 * hstepB;
    const unsigned ldsw = (unsigned)wid * 1024u;
    const int aoff = lds_byte(wr * 64 + fr, fq * 8), boff = lds_byte(wc * 32 + fr, fq * 8);
#define PG8_SA(b, h) (((b) * 2 + (h)) * HTB)
#define PG8_SB(b, h) ((4 + (b) * 2 + (h)) * HTB)
#define PG8_STAGE(bufoff, gbase, voff) do { _Pragma("unroll") for (int _i = 0; _i < 2; ++_i) \
        __builtin_amdgcn_global_load_lds((const unsigned*)((const char*)(gbase) + (voff)[_i]), (PG8_LAS unsigned*)(lds + (bufoff) + ldsw + _i * 8192), 16, 0, 0); } while (0)
#define PG8_LDA(dst, b, h) do { _Pragma("unroll") for (int m = 0; m < 4; ++m) _Pragma("unroll") for (int k = 0; k < 2; ++k) dst[m][k] = *(const PG8_LAS bf16x8*)(lds + PG8_SA(b, h) + aoff + m * 2048 + k * 1024); } while (0)
#define PG8_LDB(dst, b, h) do { _Pragma("unroll") for (int n = 0; n < 2; ++n) _Pragma("unroll") for (int k = 0; k < 2; ++k) dst[n][k] = *(const PG8_LAS bf16x8*)(lds + PG8_SB(b, h) + boff + n * 2048 + k * 1024); } while (0)
#define PG8_MMA(ai, bj, At, Bt) do { __builtin_amdgcn_s_setprio(1); _Pragma("unroll") for (int m = 0; m < 4; ++m) _Pragma("unroll") for (int n = 0; n < 2; ++n) _Pragma("unroll") for (int k = 0; k < 2; ++k) \
        acc[ai][bj][m][n] = __builtin_amdgcn_mfma_f32_16x16x32_bf16(Bt[n][k], At[m][k], acc[ai][bj][m][n], 0, 0, 0); __builtin_amdgcn_s_setprio(0); } while (0)
#define PG8_WAIT_V(n) asm volatile("s_waitcnt vmcnt(" #n ")" ::: "memory")
#define PG8_WAIT_L(n) asm volatile("s_waitcnt lgkmcnt(" #n ")" ::: "memory")
#define PG8_BAR __builtin_amdgcn_s_barrier()
#define PG8_SCHED __builtin_amdgcn_sched_barrier(0)
    Unit cur, nxt; int ui = 0;
    if (!S.next(0, cur)) return;
    f32x4 acc[2][2][4][2];
#pragma unroll
    for (int a = 0; a < 2; ++a)
#pragma unroll
        for (int b = 0; b < 2; ++b)
#pragma unroll
            for (int m = 0; m < 4; ++m)
#pragma unroll
                for (int n = 0; n < 2; ++n) acc[a][b][m][n] = (f32x4){0.f, 0.f, 0.f, 0.f};
    bf16x8 At[4][2], B0[2][2], B1[2][2];
    const char* cA = (const char*)g.A + (size_t)cur.pm * tstepA; const char* cB = (const char*)g.Bt + (size_t)cur.pn * tstepB;
    S.a_ready(cur);
    if constexpr (SP2) {
        PG8_STAGE(PG8_SB(0, 0), cB, voffB); PG8_STAGE(PG8_SB(0, 1), cB + hstepB, voffB); PG8_STAGE(PG8_SA(0, 0), cA, voffA); PG8_STAGE(PG8_SA(0, 1), cA + hstepA, voffA);
        if (wr == 1) PG8_BAR;
        PG8_WAIT_V(2); PG8_BAR;
        PG8_STAGE(PG8_SB(1, 0), cB + kstep, voffB); PG8_STAGE(PG8_SA(1, 0), cA + kstep, voffA); PG8_STAGE(PG8_SB(1, 1), cB + hstepB + kstep, voffB);
        PG8_WAIT_V(6); PG8_BAR;
    } else {
        PG8_STAGE(PG8_SB(0, 0), cB, voffB); PG8_STAGE(PG8_SA(0, 0), cA, voffA); PG8_STAGE(PG8_SB(0, 1), cB + hstepB, voffB); PG8_STAGE(PG8_SA(0, 1), cA + hstepA, voffA);
        if (wr == 1) PG8_BAR;
        PG8_WAIT_V(4); PG8_BAR;
        PG8_STAGE(PG8_SB(1, 0), cB + kstep, voffB); PG8_STAGE(PG8_SA(1, 0), cA + kstep, voffA); PG8_STAGE(PG8_SB(1, 1), cB + hstepB + kstep, voffB);
        PG8_WAIT_V(6); PG8_BAR;
    }
    for (;;) {
        const bool has_next = S.next(ui + 1, nxt);
        const char* nA = has_next ? (const char*)g.A + (size_t)nxt.pm * tstepA : cA; const char* nB = has_next ? (const char*)g.Bt + (size_t)nxt.pn * tstepB : cB;
#pragma unroll 1
        for (int t = 0; t < nt; t += 2) {
            const bool last = (t == nt - 2);
            const char* a1 = cA + (size_t)(t + 1) * kstep;
            const char* a2 = last ? nA : cA + (size_t)(t + 2) * kstep; const char* b2 = last ? nB : cB + (size_t)(t + 2) * kstep;
            const char* a3 = a2 + kstep; const char* b3 = b2 + kstep;
            if (last && has_next) S.a_ready(nxt);
            if constexpr (SP2) {
            PG8_LDB(B0, 0, 0); PG8_LDB(B1, 0, 1); PG8_SCHED; PG8_LDA(At, 0, 0); PG8_STAGE(PG8_SA(1, 1), a1 + hstepA, voffA);
            PG8_WAIT_V(8); PG8_WAIT_L(0); PG8_BAR; PG8_MMA(0, 0, At, B0); PG8_MMA(0, 1, At, B1); PG8_BAR; PG8_SCHED;
            PG8_LDA(At, 0, 1); PG8_STAGE(PG8_SB(0, 0), b2, voffB); PG8_STAGE(PG8_SB(0, 1), b2 + hstepB, voffB); PG8_STAGE(PG8_SA(0, 0), a2, voffA);
            PG8_WAIT_V(8); PG8_WAIT_L(0); PG8_BAR; PG8_MMA(1, 0, At, B0); PG8_MMA(1, 1, At, B1); PG8_BAR; PG8_SCHED;
            PG8_LDB(B0, 1, 0); PG8_LDB(B1, 1, 1); PG8_SCHED; PG8_LDA(At, 1, 0); PG8_STAGE(PG8_SA(0, 1), a2 + hstepA, voffA);
            PG8_WAIT_V(8); PG8_WAIT_L(0); PG8_BAR; PG8_MMA(0, 0, At, B0); PG8_MMA(0, 1, At, B1); PG8_BAR; PG8_SCHED;
            PG8_LDA(At, 1, 1); PG8_STAGE(PG8_SB(1, 0), b3, voffB); PG8_STAGE(PG8_SB(1, 1), b3 + hstepB, voffB); PG8_STAGE(PG8_SA(1, 0), a3, voffA);
            PG8_WAIT_V(8); PG8_WAIT_L(0); PG8_BAR; PG8_MMA(1, 0, At, B0); PG8_MMA(1, 1, At, B1); PG8_BAR; PG8_SCHED;
            } else {
            PG8_LDB(B0, 0, 0); PG8_SCHED; PG8_LDA(At, 0, 0); PG8_STAGE(PG8_SA(1, 1), a1 + hstepA, voffA);
            PG8_WAIT_L(8); PG8_BAR; PG8_WAIT_L(0); PG8_MMA(0, 0, At, B0); PG8_BAR; PG8_SCHED;
            PG8_LDB(B1, 0, 1); PG8_STAGE(PG8_SB(0, 0), b2, voffB);
            PG8_BAR; PG8_WAIT_L(0); PG8_MMA(0, 1, At, B1); PG8_BAR;
            PG8_LDA(At, 0, 1); PG8_STAGE(PG8_SA(0, 0), a2, voffA);
            PG8_BAR; PG8_WAIT_L(0); PG8_MMA(1, 0, At, B0); PG8_BAR; PG8_SCHED;
            PG8_STAGE(PG8_SB(0, 1), b2 + hstepB, voffB);
            PG8_WAIT_V(6); PG8_BAR; PG8_MMA(1, 1, At, B1); PG8_BAR;
            PG8_LDB(B0, 1, 0); PG8_SCHED; PG8_LDA(At, 1, 0); PG8_STAGE(PG8_SA(0, 1), a2 + hstepA, voffA);
            PG8_WAIT_L(8); PG8_BAR; PG8_WAIT_L(0); PG8_MMA(0, 0, At, B0); PG8_BAR; PG8_SCHED;
            PG8_LDB(B1, 1, 1); PG8_STAGE(PG8_SB(1, 0), b3, voffB);
            PG8_BAR; PG8_WAIT_L(0); PG8_MMA(0, 1, At, B1); PG8_BAR;
            PG8_LDA(At, 1, 1); PG8_STAGE(PG8_SA(1, 0), a3, voffA);
            PG8_BAR; PG8_WAIT_L(0); PG8_MMA(1, 0, At, B0); PG8_BAR; PG8_SCHED;
            PG8_STAGE(PG8_SB(1, 1), b3 + hstepB, voffB);
            PG8_WAIT_V(6); PG8_BAR; PG8_MMA(1, 1, At, B1); PG8_BAR;
            }
        }
        if constexpr (ALIGN_EPI) { if (wr == 0) PG8_BAR; }
        if constexpr (!Epi::AFTER_DRAIN) { E(acc, cur, wr, wc, fr, fq); S.done(cur); }
        if (!has_next) break;
#pragma unroll
        for (int a = 0; a < 2; ++a)
#pragma unroll
            for (int b = 0; b < 2; ++b)
#pragma unroll
                for (int m = 0; m < 4; ++m)
#pragma unroll
                    for (int n = 0; n < 2; ++n) acc[a][b][m][n] = (f32x4){0.f, 0.f, 0.f, 0.f};
        cur = nxt; cA = nA; cB = nB; ++ui;
        if constexpr (ALIGN_EPI) { if (wr == 1) PG8_BAR; }
    }
    PG8_WAIT_V(0);
    if constexpr (!ALIGN_EPI) { if (wr == 0) PG8_BAR; }
    PG8_BAR;
    if constexpr (Epi::AFTER_DRAIN) { E.fused(acc, cur, wr, wc, fr, fq, lds, wid, lane); S.done(cur); }
#undef PG8_SA
#undef PG8_SB
#undef PG8_STAGE
#undef PG8_LDA
#undef PG8_LDB
#undef PG8_MMA
#undef PG8_WAIT_V
#undef PG8_WAIT_L
#undef PG8_BAR
#undef PG8_SCHED
}
}
#include <hip/hip_bf16.h>
#include <cmath>
namespace attn_body {
using bf16=__hip_bfloat16;
using bf16x8=__attribute__((ext_vector_type(8)))short;
using s16x4=__attribute__((ext_vector_type(4)))short;
using f32x16=__attribute__((ext_vector_type(16)))float;
using u32x4=__attribute__((ext_vector_type(4)))unsigned;
constexpr int BATCH=2,NHEAD=4,SEQ=16384,D=64,DM=NHEAD*D,ODM=1024;
constexpr int NW=8,QBLK=32,QB=QBLK*NW,KVBLK=64,NQB=SEQ/QB;
constexpr int ATTN_PITCH=DM, ATTN_UNIT_ROWS=QB;
__device__ __forceinline__ int crow(int r,int hi){return (r&3)+8*(r>>2)+4*hi;}
#define SBAR() __builtin_amdgcn_sched_barrier(0)
__device__ __forceinline__ void cmask(f32x16&p0,f32x16&p1,int jb,int qrel,int hi){
  const float NEG=-INFINITY; int kb=64*jb+4*hi;
  #pragma unroll
  for(int r=0;r<16;++r){int kv=kb+(r&3)+8*(r>>2); if(kv>qrel)p0[r]=NEG; if(kv+32>qrel)p1[r]=NEG;}
}

constexpr int NSLOT=3, SLOTB=8192;
constexpr int LDS_K=0, LDS_V=NSLOT*SLOTB, LDS_WS=2*NSLOT*SLOTB, LDS_OST=LDS_WS+NW*64*4, LDS_BYTES=LDS_OST+NW*4096;
constexpr float C2=0.125f*1.4426950408889634f;
__device__ __forceinline__ void glds16(const void*gsrc,unsigned lds_dst){unsigned keep;
  asm volatile("s_mov_b32 %0, m0\n\ts_mov_b32 m0, %2\n\ts_nop 0\n\tglobal_load_lds_dwordx4 %1, off\n\ts_mov_b32 m0, %0":"=&s"(keep):"v"(gsrc),"s"(lds_dst):"memory");}
__device__ __forceinline__ float max3f(float a,float b,float c){float r;asm("v_max3_f32 %0, %1, %2, %3":"=v"(r):"v"(a),"v"(b),"v"(c));return r;}
__device__ __forceinline__ float max2f(float a,float b){float r;asm("v_max_f32_e32 %0, %1, %2":"=v"(r):"v"(a),"v"(b));return r;}
__device__ __forceinline__ float fadd_s(float a,float b){float r;asm("v_add_f32_e32 %0, %1, %2":"=v"(r):"v"(a),"v"(b));return r;}
__device__ __forceinline__ float fsub_s(float a,float b){float r;asm("v_sub_f32_e32 %0, %1, %2":"=v"(r):"v"(a),"v"(b));return r;}
typedef float f32x2_t __attribute__((ext_vector_type(2))); typedef __bf16 bf16x2_t __attribute__((ext_vector_type(2)));
__device__ __forceinline__ unsigned cvtpk_s(float lo,float hi){f32x2_t v={lo,hi};bf16x2_t b=__builtin_convertvector(v,bf16x2_t);return __builtin_bit_cast(unsigned,b);}
#define WAIT_BAR(N) asm volatile("s_waitcnt vmcnt(" #N ") lgkmcnt(0)\n\ts_barrier":::"memory")

__device__ __forceinline__ void qkt(f32x16&p0,f32x16&p1,const char*Kslot,const bf16x8*qr,const f32x16&negm,int r32,int hi){
  const char*kb=Kslot+hi*1024+r32*16;
  #pragma unroll
  for(int d0=0;d0<3;++d0){
    const bf16x8 b0=*reinterpret_cast<const bf16x8*>(kb+d0*2048);
    const bf16x8 b1=*reinterpret_cast<const bf16x8*>(kb+d0*2048+512);
    if(d0==0){p0=__builtin_amdgcn_mfma_f32_32x32x16_bf16(b0,qr[0],negm,0,0,0);p1=__builtin_amdgcn_mfma_f32_32x32x16_bf16(b1,qr[0],negm,0,0,0);}
    else{p0=__builtin_amdgcn_mfma_f32_32x32x16_bf16(b0,qr[d0],p0,0,0,0);p1=__builtin_amdgcn_mfma_f32_32x32x16_bf16(b1,qr[d0],p1,0,0,0);}}
}
typedef __attribute__((address_space(3))) const char* lds_cptr;
typedef short v4i16_t __attribute__((ext_vector_type(4)));
__device__ __forceinline__ void kload8(bf16x8*kf,lds_cptr kp){
  kf[0]=*(const __attribute__((address_space(3))) bf16x8*)(kp);      kf[1]=*(const __attribute__((address_space(3))) bf16x8*)(kp+512);
  kf[2]=*(const __attribute__((address_space(3))) bf16x8*)(kp+2048); kf[3]=*(const __attribute__((address_space(3))) bf16x8*)(kp+2560);
  kf[4]=*(const __attribute__((address_space(3))) bf16x8*)(kp+4096); kf[5]=*(const __attribute__((address_space(3))) bf16x8*)(kp+4608);
}
__device__ __forceinline__ void kload2(bf16x8*kf,lds_cptr kp,int j){ kf[2*j]=*(const __attribute__((address_space(3))) bf16x8*)(kp+j*2048); kf[2*j+1]=*(const __attribute__((address_space(3))) bf16x8*)(kp+j*2048+512); }
__device__ __forceinline__ s16x4 vtr(lds_cptr p){ return __builtin_bit_cast(s16x4,__builtin_amdgcn_ds_read_tr16_b64_v4i16((__attribute__((address_space(3))) v4i16_t*)p)); }
__device__ __forceinline__ float rowmax(const f32x16&p0,const f32x16&p1){
  float a=max3f(p0[0],p0[1],p1[0]),b=max3f(p0[2],p0[3],p1[1]);a=max3f(a,p1[2],p1[3]);
  #pragma unroll
  for(int r=4;r<16;r+=4){a=max3f(a,p0[r],p0[r+1]);b=max3f(b,p0[r+2],p0[r+3]);a=max3f(a,p1[r],p1[r+1]);b=max3f(b,p1[r+2],p1[r+3]);}
  const float m=max2f(a,b);
  auto rr=__builtin_amdgcn_permlane32_swap(__float_as_uint(m),__float_as_uint(m),false,false);
  return max2f(__uint_as_float(rr[0]),__uint_as_float(rr[1]));
}
__device__ __forceinline__ void pv(f32x16*o,int vb,bf16x8 pa0,bf16x8 pa1,bf16x8 pa2,bf16x8 pa3){
  #pragma unroll
  for(int d0=0;d0<2;++d0){s16x4 lo[4],hi[4];
    #pragma unroll
    for(int ks=0;ks<4;++ks){
      asm volatile("ds_read_b64_tr_b16 %0,%1 offset:%c2":"=&v"(lo[ks]):"v"(vb),"i"(d0*4096+ks*1024):"memory");
      asm volatile("ds_read_b64_tr_b16 %0,%1 offset:%c2":"=&v"(hi[ks]):"v"(vb),"i"(d0*4096+ks*1024+512):"memory");}
    asm volatile("s_waitcnt lgkmcnt(0)":::"memory");SBAR();
    #define PK(k) (bf16x8){lo[k][0],lo[k][1],lo[k][2],lo[k][3],hi[k][0],hi[k][1],hi[k][2],hi[k][3]}
    o[d0]=__builtin_amdgcn_mfma_f32_32x32x16_bf16(pa0,PK(0),o[d0],0,0,0);
    o[d0]=__builtin_amdgcn_mfma_f32_32x32x16_bf16(pa1,PK(1),o[d0],0,0,0);
    o[d0]=__builtin_amdgcn_mfma_f32_32x32x16_bf16(pa2,PK(2),o[d0],0,0,0);
    o[d0]=__builtin_amdgcn_mfma_f32_32x32x16_bf16(pa3,PK(3),o[d0],0,0,0);
    #undef PK
  }
}

#ifndef ATTN_STORE16
#define ATTN_STORE16(p,v) (*(u32x4*)(p)=(v))
#endif
template<int THRL> __device__ __forceinline__ void attn_unit(int b,int h,int qb,const bf16*Q,const bf16*__restrict__ K,const bf16*__restrict__ V,bf16*O,char*shm,int wv){
  const int tid=ltid(wv),lane=tid&63,r32=lane&31,hi=lane>>5; const int wid=__builtin_amdgcn_readfirstlane(tid>>6);
  const long rowbase=(long)b*SEQ; const int q0=qb*QB;
  const bf16*Qw=Q+(rowbase+q0+wid*QBLK)*DM+h*D;
  const bf16*Kh=K+rowbase*DM+h*D,*Vh=V+rowbase*DM+h*D;
  const unsigned lds0=(unsigned)(uintptr_t)shm;
  float*wsf=(float*)(shm+LDS_WS)+wid*64;
  const bf16*ksrc=Kh+(long)lane*DM+wid*8;
  const bf16*vsrc=Vh+(long)(16*(wid&3)+(lane>>2))*DM+(wid>>2)*32+(lane&3)*8;
  const unsigned kdst=lds0+LDS_K+wid*1024, vdst=lds0+LDS_V+wid*1024;
  #define DMA_K(t,slot) glds16(ksrc+(long)(t)*KVBLK*DM,(unsigned)__builtin_amdgcn_readfirstlane(kdst+(slot)))
  #define DMA_V(t,slot) glds16(vsrc+(long)(t)*KVBLK*DM,(unsigned)__builtin_amdgcn_readfirstlane(vdst+(slot)))
  const int vb0=(int)(lds0+LDS_V)+((lane>>4)&1)*32+(lane&3)*8+(4*hi+((lane&15)>>2))*64;
  const char*Kbase=shm+LDS_K; bf16x8 kf[8];
  const lds_cptr shm3=(lds_cptr)shm; const lds_cptr kp0=shm3+LDS_K+hi*1024+r32*16; const lds_cptr vp0=shm3+LDS_V+((lane>>4)&1)*32+(lane&3)*8+(4*hi+((lane&15)>>2))*64;
  const int NT=(q0+QB)/KVBLK;
  DMA_K(0,0);DMA_V(0,0);DMA_K(1,SLOTB);
  bf16x8 qr[4];
  #pragma unroll
  for(int d0=0;d0<3;++d0)qr[d0]=*reinterpret_cast<const bf16x8*>(&Qw[(long)r32*DM+d0*16+hi*8]);
  float mhat=0.f,l_reg=0.f;f32x16 o[2];o[0]=f32x16{};o[1]=f32x16{};f32x16 negm=f32x16{};asm volatile("":"+v"(negm));
  const int qrel=wid*QBLK+r32;
  #define CMASK(P0,P1,t) do{int jb_=(t)-(NT-4); if(jb_>=0)cmask(P0,P1,jb_,qrel,hi);}while(0)
  bool resc=false;
  #define START(P0,P1) do{ const float rm=rowmax(P0,P1); resc=false; \
    { const float dl=rm; mhat=fadd_s(mhat,dl); \
      _Pragma("unroll") for(int r=0;r<16;++r){P0[r]=fsub_s(P0[r],dl);P1[r]=fsub_s(P1[r],dl);} \
      _Pragma("unroll") for(int r=0;r<16;++r)negm[r]=-mhat; asm volatile("":"+v"(negm)); } \
    _Pragma("unroll") for(int r=0;r<16;++r)P0[r]=__builtin_amdgcn_exp2f(P0[r]); }while(0)
  #define RESC() do{ if(resc){ asm volatile("s_waitcnt lgkmcnt(0)":::"memory"); \
      _Pragma("unroll") for(int d_=0;d_<2;++d_) _Pragma("unroll") for(int r=0;r<16;++r)o[d_][r]*=wsf[crow(r,hi)]; } }while(0)
  f32x16 pA0,pA1,pB0,pB1;
  int sl_prev=0,sl_cur=0,sl_next=SLOTB;
  #define ROT() do{sl_prev=sl_cur;sl_cur=sl_next;sl_next=(sl_next==(NSLOT-1)*SLOTB)?0:sl_next+SLOTB;}while(0)
  DMA_K(2,2*SLOTB);
  WAIT_BAR(3);
  qkt(pA0,pA1,Kbase,qr,negm,r32,hi);asm volatile("s_nop 15\n\ts_nop 7":"+v"(pA0),"+v"(pA1));CMASK(pA0,pA1,0);
  START(pA0,pA1);
  _Pragma("unroll") for(int r=0;r<16;++r)pA1[r]=__builtin_amdgcn_exp2f(pA1[r]);
  WAIT_BAR(0);
  DMA_K(3,0);DMA_V(1,SLOTB);
  ROT();
  kload8(kf,kp0+sl_cur);
  WAIT_BAR(2);
  s16x4 vlo[8],vhi[8]; u32x4 pw0,pw1,pw2,pw3;
  #define PKW(P,B) cvtpk_s(P[B],P[B+1])
  #define PAF(k) __builtin_bit_cast(bf16x8,pw##k)
  #define VFR(i) (bf16x8){vlo[i][0],vlo[i][1],vlo[i][2],vlo[i][3],vhi[i][0],vhi[i][1],vhi[i][2],vhi[i][3]}
  #define PIN(x) asm volatile("":"+v"(x))
  #define MX3(a,b,c) __builtin_fmaxf(__builtin_fmaxf((a),(b)),(c))
  #define GAPA(MF,A0,A1,A2,A3,W0,W1,PW) do{ MF; sacc+=(f32x2_t){A0,A1}; sacc+=(f32x2_t){A2,A3}; PIN(sacc); W0; W1; PIN(PW); SBAR(); }while(0)
  #define EX(v) __builtin_amdgcn_exp2f(v)
  #define GAPB(MF,X,B) do{ MF; X[B]=EX(X[B]); X[B+1]=EX(X[B+1]); X[B+2]=EX(X[B+2]); X[B+3]=EX(X[B+3]); PIN(X); SBAR(); }while(0)
  #define VRD(i) do{ vlo[i]=vtr(vp_+(((i)>>2)*4096+((i)&3)*1024)); vhi[i]=vtr(vp_+(((i)>>2)*4096+((i)&3)*1024+512)); }while(0)
  #define KRD(G,j) do{ if(G){ kload2(kf,kp0+sl_next,j); SBAR(); } }while(0)
  #define STEP(C0,C1,P0,P1,t,GK,GV,GL) do{ SBAR(); \
    const lds_cptr vp_=vp0+sl_prev; \
    VRD(0); SBAR(); f32x2_t sacc=(f32x2_t){P0[0],P0[1]}; \
    GAPA(C0=__builtin_amdgcn_mfma_f32_32x32x16_bf16(kf[0],qr[0],negm,0,0,0), P0[2],P0[3],P0[4],P0[5],     pw0[0]=PKW(P0,0), pw0[1]=PKW(P0,2), pw0); \
    VRD(4); SBAR(); GAPA(C1=__builtin_amdgcn_mfma_f32_32x32x16_bf16(kf[1],qr[0],negm,0,0,0), P0[6],P0[7],P0[8],P0[9],     pw0[2]=PKW(P0,4), pw0[3]=PKW(P0,6), pw0); \
    VRD(1); SBAR(); GAPA(C0=__builtin_amdgcn_mfma_f32_32x32x16_bf16(kf[2],qr[1],C0,0,0,0),   P0[10],P0[11],P0[12],P0[13], pw1[0]=PKW(P0,8), pw1[1]=PKW(P0,10), pw1); \
    VRD(5); SBAR(); GAPA(C1=__builtin_amdgcn_mfma_f32_32x32x16_bf16(kf[3],qr[1],C1,0,0,0),   P0[14],P0[15],P1[0],P1[1],   pw1[2]=PKW(P0,12),pw1[3]=PKW(P0,14), pw1); \
    VRD(2); SBAR(); GAPA(C0=__builtin_amdgcn_mfma_f32_32x32x16_bf16(kf[4],qr[2],C0,0,0,0),   P1[2],P1[3],P1[4],P1[5],     pw2[0]=PKW(P1,0), pw2[1]=PKW(P1,2), pw2); \
    VRD(6); SBAR(); GAPA(C1=__builtin_amdgcn_mfma_f32_32x32x16_bf16(kf[5],qr[2],C1,0,0,0),   P1[6],P1[7],P1[8],P1[9],     pw2[2]=PKW(P1,4), pw2[3]=PKW(P1,6), pw2); \
    VRD(3); SBAR(); GAPA((void)0,   P1[10],P1[11],P1[12],P1[13], pw3[0]=PKW(P1,8), pw3[1]=PKW(P1,10), pw3); \
    VRD(7); SBAR(); GAPA((void)0,   P1[14],P1[15],0.f,0.f,       pw3[2]=PKW(P1,12),pw3[3]=PKW(P1,14), pw3); \
    l_reg+=(sacc.x+sacc.y); \
    if(GK){DMA_K((t)+3,sl_cur);} if(GV){DMA_V((t)+1,sl_next);} \
    CMASK(C0,C1,t); \
    { float a=MX3(C0[0],C0[1],C1[0]),b=MX3(C0[2],C0[3],C1[1]); a=MX3(a,C1[2],C1[3]); \
      _Pragma("unroll") for(int r=4;r<16;r+=4){a=MX3(a,C0[r],C0[r+1]);b=MX3(b,C0[r+2],C0[r+3]);a=MX3(a,C1[r],C1[r+1]);b=MX3(b,C1[r+2],C1[r+3]);} \
      float rm=__builtin_fmaxf(a,b); { auto rr=__builtin_amdgcn_permlane32_swap(__float_as_uint(rm),__float_as_uint(rm),false,false); rm=__builtin_fmaxf(__uint_as_float(rr[0]),__uint_as_float(rr[1])); } \
      resc=false; \
      if(__builtin_expect(__any(rm>(float)THRL),0)){ const float dl=__builtin_fmaxf(rm,0.f); mhat+=dl; \
        _Pragma("unroll") for(int r=0;r<16;++r){C0[r]-=dl;C1[r]-=dl;} \
        _Pragma("unroll") for(int r=0;r<16;++r)negm[r]=-mhat; asm volatile("":"+v"(negm)); \
        const float f=__builtin_amdgcn_exp2f(-dl); l_reg*=f; if(hi==0)wsf[r32]=f; resc=true; } } \
    SBAR(); \
    GAPB(o[0]=__builtin_amdgcn_mfma_f32_32x32x16_bf16(PAF(0),VFR(0),o[0],0,0,0), C0,0); \
    GAPB(o[1]=__builtin_amdgcn_mfma_f32_32x32x16_bf16(PAF(0),VFR(4),o[1],0,0,0), C0,4); \
    KRD(GL,0); GAPB(o[0]=__builtin_amdgcn_mfma_f32_32x32x16_bf16(PAF(1),VFR(1),o[0],0,0,0), C0,8); \
    KRD(GL,1); GAPB(o[1]=__builtin_amdgcn_mfma_f32_32x32x16_bf16(PAF(1),VFR(5),o[1],0,0,0), C0,12); \
    KRD(GL,2); GAPB(o[0]=__builtin_amdgcn_mfma_f32_32x32x16_bf16(PAF(2),VFR(2),o[0],0,0,0), C1,0); \
    GAPB(o[1]=__builtin_amdgcn_mfma_f32_32x32x16_bf16(PAF(2),VFR(6),o[1],0,0,0), C1,4); \
    GAPB(o[0]=__builtin_amdgcn_mfma_f32_32x32x16_bf16(PAF(3),VFR(3),o[0],0,0,0), C1,8); \
    GAPB(o[1]=__builtin_amdgcn_mfma_f32_32x32x16_bf16(PAF(3),VFR(7),o[1],0,0,0), C1,12); \
    }while(0)
  int t=1;
  #undef CMASK
  #define CMASK(P0,P1,t) do{}while(0)
  for(;t+5<NT;t+=2){
    STEP(pB0,pB1,pA0,pA1,t,true,true,true);     WAIT_BAR(2); RESC(); ROT();
    STEP(pA0,pA1,pB0,pB1,t+1,true,true,true);   WAIT_BAR(2); RESC(); ROT();
  }
  #undef CMASK
  #define CMASK(P0,P1,t) do{int jb_=(t)-(NT-4); if(jb_>=0)cmask(P0,P1,jb_,qrel,hi);}while(0)
  #define ENDW(tt) do{ if((tt)+3<NT){WAIT_BAR(2);} else if((tt)+2<NT){WAIT_BAR(1);} else {WAIT_BAR(0);} }while(0)
  for(;t+1<NT;t+=2){
    STEP(pB0,pB1,pA0,pA1,t,(t+3<NT),(t+1<NT),(t+1<NT));       ENDW(t);   RESC(); ROT();
    STEP(pA0,pA1,pB0,pB1,t+1,(t+4<NT),(t+2<NT),(t+2<NT));     ENDW(t+1); RESC(); ROT();
  }
  STEP(pB0,pB1,pA0,pA1,NT-1,false,false,false); RESC();
  { float sacc=pB0[0]+pB0[1]; _Pragma("unroll") for(int r=2;r<16;++r)sacc+=pB0[r]; _Pragma("unroll") for(int r=0;r<16;++r)sacc+=pB1[r]; l_reg+=sacc;
    pw0=(u32x4){PKW(pB0,0),PKW(pB0,2),PKW(pB0,4),PKW(pB0,6)};pw1=(u32x4){PKW(pB0,8),PKW(pB0,10),PKW(pB0,12),PKW(pB0,14)};pw2=(u32x4){PKW(pB1,0),PKW(pB1,2),PKW(pB1,4),PKW(pB1,6)};pw3=(u32x4){PKW(pB1,8),PKW(pB1,10),PKW(pB1,12),PKW(pB1,14)};
    SBAR(); pv(o,vb0+sl_cur,PAF(0),PAF(1),PAF(2),PAF(3)); }
  #undef PKW
  #undef PAF
  #undef VFR
  #undef PIN
  #undef MX3
  #undef GAPA
  #undef GAPB
  #undef EX
  #undef VRD
  #undef KRD
  #undef STEP
  #undef ENDW
  {auto rr=__builtin_amdgcn_permlane32_swap(__float_as_uint(l_reg),__float_as_uint(l_reg),false,false);l_reg=__uint_as_float(rr[0])+__uint_as_float(rr[1]);}
  if(hi==0)wsf[32+r32]=l_reg;asm volatile("s_waitcnt lgkmcnt(0)":::"memory");
  float rli[16];
  #pragma unroll
  for(int r=0;r<16;++r)rli[r]=__builtin_amdgcn_rcpf(wsf[32+crow(r,hi)]);
  bf16*Ow=O+(rowbase+q0+wid*QBLK)*ODM+h*D;
  { bf16*stg=(bf16*)(shm+LDS_OST)+wid*2048;
    #pragma unroll
    for(int r=0;r<16;++r){const int orow=crow(r,hi);
      #pragma unroll
      for(int d0=0;d0<2;++d0)stg[orow*64+d0*32+r32]=__float2bfloat16(o[d0][r]*rli[r]);}
    asm volatile("s_waitcnt lgkmcnt(0)":::"memory");
    #pragma unroll
    for(int i=0;i<4;++i){const int row=i*8+(lane>>3),ch=lane&7; const u32x4 v=*(const u32x4*)(stg+row*64+ch*8); ATTN_STORE16(Ow+(long)row*ODM+ch*8,v);} }
  asm volatile("s_waitcnt lgkmcnt(0)\n\ts_barrier":::"memory");
  #undef DMA_K
  #undef DMA_V
  #undef CMASK
  #undef START
  #undef RESC
  #undef ROT
}
constexpr int ATTN_LDS_BYTES=LDS_BYTES;
struct AttnTensors { const bf16* Q; const bf16* K; const bf16* V; bf16* O; };
struct AttnUnit { int bh; int qb; };
struct StaticOrder {
  int vcu, G;
  __device__ __forceinline__ explicit StaticOrder(int grid,int block):vcu((grid%8==0)?(block%8)*(grid/8)+block/8:block),G(grid){}
  __device__ __forceinline__ bool next(int i,AttnUnit&u)const{ const int pair=vcu+(i>>1)*G; if(pair>=BATCH*NHEAD*(NQB/2))return false; const int s=pair%(NQB/2); u.bh=pair/(NQB/2); u.qb=(i&1)?(NQB-1-s):s; return true; }
  __device__ __forceinline__ void a_ready(const AttnUnit&)const{}
  __device__ __forceinline__ void done(const AttnUnit&)const{}
};
template<class Sched,int THRL=8> __device__ __forceinline__ void attn_phase(char*lds,const AttnTensors&T,const Sched&S,int wv){
  AttnUnit u;
  for(int i=0;S.next(i,u);++i){ S.a_ready(u); attn_unit<THRL>(u.bh/NHEAD,u.bh%NHEAD,u.qb,T.Q,T.K,T.V,T.O,lds,wv); S.done(u); }
}
#undef SBAR
#undef WAIT_BAR
}
namespace cg = cooperative_groups;
#define DI __device__ __forceinline__
#define LAS __attribute__((address_space(3)))
typedef unsigned short bf16_t;
typedef short bf16x8 __attribute__((ext_vector_type(8)));
typedef float f32x4 __attribute__((ext_vector_type(4)));
typedef float f32x2 __attribute__((ext_vector_type(2)));
typedef unsigned u32x4 __attribute__((ext_vector_type(4)));
typedef unsigned u32x2 __attribute__((ext_vector_type(2)));

#define XB_TMO      128
#define XB_XCNT(j)  (256  + 64 * (j))
#define XB_XSUB(j)  (1280 + 64 * (j))
#define XB_XGEN(j)  (2304 + 64 * (j))
#define XB_TOP      3328
#define XB_TOPGEN   3392
#define XCD_BAR_WORDS 3456
#define XB_SPIN_CAP (1u << 18)

__device__ __forceinline__ unsigned xb_ld(unsigned* p)              { return __hip_atomic_load(p, __ATOMIC_RELAXED, __HIP_MEMORY_SCOPE_AGENT); }
__device__ __forceinline__ unsigned xb_add(unsigned* p, unsigned v) { return __hip_atomic_fetch_add(p, v, __ATOMIC_RELAXED, __HIP_MEMORY_SCOPE_AGENT); }
__device__ __forceinline__ unsigned xb_xcc_id() { return (unsigned)__builtin_amdgcn_s_getreg((3 << 11) | 20) & 0xFu; }
#define XB_SPIN(cond, bar) do { unsigned _sp = 0; while (cond) { __builtin_amdgcn_s_sleep(1); \
    if ((++_sp & 255u) == 0u) { if (xb_ld(&(bar)[XB_TMO])) break; if (_sp > XB_SPIN_CAP) { atomicAdd(&(bar)[XB_TMO], 1u); break; } } } } while (0)

struct XcdBarrier {
    unsigned* bar; unsigned x;
    volatile LAS unsigned* st;
};

__device__ __forceinline__ XcdBarrier xcd_barrier_post(unsigned* bar, volatile LAS unsigned* st, int wv) {
    XcdBarrier b; b.bar = bar; b.x = xb_xcc_id(); b.st = st;
    if (ltid(wv) == 0) (void)xb_add(&bar[XB_XCNT(b.x)], 1u);
    return b;
}
__device__ __forceinline__ void xcd_barrier_complete(unsigned* bar, unsigned x, unsigned& nloc, unsigned& nx) {
    const unsigned G = gridDim.x * gridDim.y * gridDim.z;
    unsigned sum, cnt, mine, sp = 0u;
    for (;;) {
        sum = 0u; cnt = 0u; mine = 0u;
#pragma unroll
        for (unsigned j = 0; j < 16; ++j) { const unsigned c = xb_ld(&bar[XB_XCNT(j)]); sum += c; cnt += (c > 0u) ? 1u : 0u; mine = (j == x) ? c : mine; }
        if (sum == G) break;
        __builtin_amdgcn_s_sleep(1);
        if ((++sp & 255u) == 0u) { if (xb_ld(&bar[XB_TMO])) break; if (sp > XB_SPIN_CAP) { atomicAdd(&bar[XB_TMO], 1u); break; } }
    }
    nloc = mine > 0u ? mine : 1u; nx = cnt > 0u ? cnt : 1u;
}

__device__ __forceinline__ void xcd_barrier(const XcdBarrier& b, int wv) {
    asm volatile("s_waitcnt vmcnt(0)" ::: "memory");
    __syncthreads();
    if (ltid(wv) == 0) {
        unsigned* bar = b.bar;
        __builtin_amdgcn_s_waitcnt(0);
        unsigned nloc = b.st[0], nx = b.st[1];
        if (nloc == 0u) { xcd_barrier_complete(bar, b.x, nloc, nx); b.st[0] = nloc; b.st[1] = nx; }
        const unsigned old = xb_add(&bar[XB_XSUB(b.x)], 1u);
        const unsigned gen = old / nloc;
        if (old + 1u == (gen + 1u) * nloc) {
            __builtin_amdgcn_fence(__ATOMIC_RELEASE, "agent");
            asm volatile("s_waitcnt vmcnt(0)" ::: "memory");
            const unsigned og = xb_add(&bar[XB_TOP], 1u);
            const unsigned tg = og / nx;
            if (og + 1u == (tg + 1u) * nx) xb_add(&bar[XB_TOPGEN], 1u);
            else XB_SPIN(xb_ld(&bar[XB_TOPGEN]) == tg, bar);
            __builtin_amdgcn_fence(__ATOMIC_ACQUIRE, "agent");
            xb_add(&bar[XB_XGEN(b.x)], 1u);
            asm volatile("s_waitcnt vmcnt(0)" ::: "memory");
        } else {
            XB_SPIN(xb_ld(&bar[XB_XGEN(b.x)]) == gen, bar);
            __builtin_amdgcn_fence(__ATOMIC_ACQUIRE, "agent");
            asm volatile("s_waitcnt vmcnt(0)" ::: "memory");
        }
    }
    __syncthreads();
}

constexpr int SEQ = 16384, NB = 2, T = NB * SEQ, DMODEL = 1024, NIN = 2964, HP = 3072, DFF = 2816, NCH = SEQ / 128;
constexpr float EPS = 1e-5f, ALPHA = 1.4142135623730951f;
constexpr int C_CQ = 0, C_CKV = 256, C_KR = 384, C_Z = 400, C_XBC = 656, C_RQ = 1424, C_RK = 1680, C_RV = 1936, C_RG = 2192, C_LX = 2448, C_LG = 2704, C_DT = 2960;
constexpr float QSCALE = 0.14433756729740643f * 1.4426950408889634f;

constexpr size_t MiB = 1u << 20;
constexpr size_t WS_W = 1 * MiB;
constexpr size_t W_IN = 0, W_OUT = 6 * MiB, W_F1 = 8 * MiB, W_F2 = 19 * MiB, W_UQ = 24 * MiB + 512 * 1024, W_UKV = W_UQ + 128 * 1024, W_LRU = W_UKV + 256 * 1024;
constexpr size_t WS_ROPE16 = 27 * MiB, WS_ROPE64 = 29 * MiB;
constexpr size_t WS_DT = 37 * MiB, WS_SSQQ = WS_DT + 512 * 1024, WS_SSQKV = WS_SSQQ + 512 * 1024, WS_SDEC = WS_SSQKV + 512 * 1024, WS_LSUM = WS_SDEC + 64 * 1024, WS_LCARRY = WS_LSUM + 512 * 1024;
constexpr size_t WS_XB = 40 * MiB, WS_H = 104 * MiB, WS_Y = 296 * MiB, WS_XF = 360 * MiB, WS_STAT1 = 488 * MiB, WS_END = 492 * MiB;
constexpr size_t WS_YT = WS_XF, WS_LSW = WS_XF + 32 * MiB;
constexpr size_t WS_LA = WS_XF + 40 * MiB, WS_LI = WS_XF + 72 * MiB;
constexpr size_t W_PART1 = 25 * MiB, W_PART2 = W_PART1 + 384 * 1024, W_C1F = W_PART2 + 384 * 1024, W_C2F = W_C1F + 32 * 1024;
constexpr size_t DO_Q = 0, DO_K = 16 * MiB, DO_V = 32 * MiB, DO_ST = 48 * MiB, DO_RS = 80 * MiB;

constexpr int LDS_BYTES = 147456;
constexpr int CW_BAR = 1024;

struct Args {
    const float* in[29];
    const int* pos;
    float* out;
    unsigned char* ws;
};

#if defined(__HIP_DEVICE_COMPILE__)
typedef const __attribute__((address_space(4))) Args* KArgs;
DI KArgs kargs() { KArgs p = (KArgs)__builtin_amdgcn_kernarg_segment_ptr(); asm volatile("" : "+s"(p)); return p; }
#else
typedef const Args* KArgs;
DI KArgs kargs() { return nullptr; }
#endif
DI float bperm(float v, int srclane) { return __int_as_float(__builtin_amdgcn_ds_bpermute(srclane << 2, __float_as_int(v))); }
DI float bf2f(unsigned short u) { return __uint_as_float((unsigned)u << 16); }
typedef __bf16 hwbf16x2 __attribute__((ext_vector_type(2)));
DI unsigned pk2(float lo, float hi) { const f32x2 v = {lo, hi}; const hwbf16x2 b = __builtin_convertvector(v, hwbf16x2); return __builtin_bit_cast(unsigned, b); }
DI unsigned short f2bf(float f) { return (unsigned short)(pk2(f, 0.f) & 0xffffu); }
DI float silu_f(float x) { return x * __builtin_amdgcn_rcpf(1.0f + __expf(-x)); }
DI float sigmoid_f(float x) { return __builtin_amdgcn_rcpf(1.0f + __expf(-x)); }
DI float softplus_f(float x) { return x > 20.f ? x : log1pf(__expf(x)); }
DI float gelu_tanh_f(float x) { const float u = 0.7978845608028654f * (x + 0.044715f * x * x * x); const float th = 1.0f - 2.0f * __builtin_amdgcn_rcpf(1.0f + __expf(2.0f * u)); return 0.5f * x * (1.0f + th); }
DI float one_minus_exp(float x) { const float p = -x * (1.0f + x * (0.5f + x * (0.16666667f + x * (0.041666668f + x * 0.008333334f)))); if (__builtin_expect(__any(x <= -0.5f), 0)) return x > -0.5f ? p : 1.0f - __expf(x); return p; }
DI void unpack8(const u32x4 v, float (&o)[8]) {
    o[0] = __uint_as_float(v.x << 16); o[1] = __uint_as_float(v.x & 0xffff0000u); o[2] = __uint_as_float(v.y << 16); o[3] = __uint_as_float(v.y & 0xffff0000u);
    o[4] = __uint_as_float(v.z << 16); o[5] = __uint_as_float(v.z & 0xffff0000u); o[6] = __uint_as_float(v.w << 16); o[7] = __uint_as_float(v.w & 0xffff0000u);
}
DI u32x4 pack8(const float (&v)[8]) { u32x4 w; w.x = pk2(v[0], v[1]); w.y = pk2(v[2], v[3]); w.z = pk2(v[4], v[5]); w.w = pk2(v[6], v[7]); return w; }

struct EpiIn {
    static constexpr bool PERM = true, AFTER_DRAIN = false;
    bf16_t* H; float* DT; float* SSQQ; float* SSQKV;
    DI void operator()(const f32x4 (&acc)[2][2][4][2], const pg8::Unit& u, int wr, int wc, int fr, int fq) const {
        asm volatile("" : "+v"(fr), "+v"(fq));
        const int row0 = u.pm * 256 + wr * 64 + fr, col0 = u.pn * 256 + wc * 32 + 8 * fq, lane = fq * 16 + fr;
#pragma unroll
        for (int ai = 0; ai < 2; ++ai)
#pragma unroll
            for (int m = 0; m < 4; ++m) {
                const int row = row0 + ai * 128 + m * 16; bf16_t* rowp = H + (size_t)row * HP + col0; float ss[2];
#pragma unroll
                for (int bj = 0; bj < 2; ++bj) { const f32x4 v0 = acc[ai][bj][m][0], v1 = acc[ai][bj][m][1];
                    u32x4 w; w.x = pk2(v0[0], v0[1]); w.y = pk2(v0[2], v0[3]); w.z = pk2(v1[0], v1[1]); w.w = pk2(v1[2], v1[3]);
                    *(u32x4*)(rowp + bj * 128) = w;
                    ss[bj] = (v0[0] * v0[0] + v0[1] * v0[1]) + (v0[2] * v0[2] + v0[3] * v0[3]) + (v1[0] * v1[0] + v1[1] * v1[1]) + (v1[2] * v1[2] + v1[3] * v1[3]); }
                if (u.pn == 0) { float s = ss[0] + ss[1]; s += bperm(s, lane ^ 16); s += bperm(s, lane ^ 32); if (fq == 0) SSQQ[(size_t)row * 4 + wc] = s; }
                else if (u.pn == 1) { float s = ss[0]; s += bperm(s, lane ^ 16); s += bperm(s, lane ^ 32); if (fq == 0) SSQKV[(size_t)row * 4 + wc] = s; }
                else if (u.pn == 11) { if (wc == 0 && fq == 2) *(f32x4*)(DT + (size_t)row * 4) = acc[ai][1][m][0]; }
            }
    }
};
DI void rope4(f32x4& v0, f32x4& v1, const float* tab_row, int fq) {
    const f32x4 cs0 = *(const f32x4*)(tab_row + 8 * fq), cs1 = *(const f32x4*)(tab_row + 8 * fq + 4);
    const float c[4] = {cs0[0], cs0[2], cs1[0], cs1[2]}, s[4] = {cs0[1], cs0[3], cs1[1], cs1[3]};
    f32x4 a, b;
#pragma unroll
    for (int j = 0; j < 4; ++j) { a[j] = v0[j] * c[j] - v1[j] * s[j]; b[j] = v0[j] * s[j] + v1[j] * c[j]; }
    v0 = a; v1 = b;
}
struct EpiQ {
    static constexpr bool PERM = true, AFTER_DRAIN = false;
    bf16_t* Q; const float* SSQ; const float* ROPE16;
    DI void operator()(const f32x4 (&acc)[2][2][4][2], const pg8::Unit& u, int wr, int wc, int fr, int fq) const {
        asm volatile("" : "+v"(fr), "+v"(fq));
        const int row0 = u.pm * 256 + wr * 64 + fr, col0 = wc * 32 + 8 * fq;
#pragma unroll
        for (int ai = 0; ai < 2; ++ai)
#pragma unroll
            for (int m = 0; m < 4; ++m) {
                const int row = row0 + ai * 128 + m * 16; const f32x4 p = *(const f32x4*)(SSQ + (size_t)row * 4);
                const float rs = QSCALE * __builtin_amdgcn_rsqf(((p[0] + p[1]) + (p[2] + p[3])) * (1.0f / 256.0f) + EPS);
#pragma unroll
                for (int bj = 0; bj < 2; ++bj) { f32x4 v0 = acc[ai][bj][m][0] * rs, v1 = acc[ai][bj][m][1] * rs;
                    if ((wc & 1) && fq < 2) rope4(v0, v1, ROPE16 + (size_t)row * 16, fq);
                    u32x4 w; w.x = pk2(v0[0], v0[1]); w.y = pk2(v0[2], v0[3]); w.z = pk2(v1[0], v1[1]); w.w = pk2(v1[2], v1[3]);
                    *(u32x4*)(Q + (size_t)row * 256 + bj * 128 + col0) = w; }
                asm volatile("" ::: "memory");
            }
    }
};
struct EpiKV {
    static constexpr bool PERM = true, AFTER_DRAIN = false;
    bf16_t* Kb; bf16_t* Vb; const bf16_t* H; const float* SSQ; const float* ROPE16;
    DI void operator()(const f32x4 (&acc)[2][2][4][2], const pg8::Unit& u, int wr, int wc, int fr, int fq) const {
        asm volatile("" : "+v"(fr), "+v"(fq));
        const int row0 = u.pm * 256 + wr * 64 + fr, col0 = wc * 32 + 8 * fq;
        bf16_t* dst = u.pn == 0 ? Kb : Vb;
#pragma unroll
        for (int ai = 0; ai < 2; ++ai)
#pragma unroll
            for (int m = 0; m < 4; ++m) {
                const int row = row0 + ai * 128 + m * 16; const f32x4 p = *(const f32x4*)(SSQ + (size_t)row * 4);
                const float rs = __builtin_amdgcn_rsqf(((p[0] + p[1]) + (p[2] + p[3])) * (1.0f / 128.0f) + EPS);
#pragma unroll
                for (int bj = 0; bj < 2; ++bj) { f32x4 v0 = acc[ai][bj][m][0] * rs, v1 = acc[ai][bj][m][1] * rs;
                    if (u.pn == 0 && (wc & 1)) {
                        if (fq < 2) { const u32x2 a = *(const u32x2*)(H + (size_t)row * HP + C_KR + 4 * fq), b = *(const u32x2*)(H + (size_t)row * HP + C_KR + 8 + 4 * fq);
                            v0 = (f32x4){__uint_as_float(a.x << 16), __uint_as_float(a.x & 0xffff0000u), __uint_as_float(a.y << 16), __uint_as_float(a.y & 0xffff0000u)};
                            v1 = (f32x4){__uint_as_float(b.x << 16), __uint_as_float(b.x & 0xffff0000u), __uint_as_float(b.y << 16), __uint_as_float(b.y & 0xffff0000u)};
                            rope4(v0, v1, ROPE16 + (size_t)row * 16, fq); }
                        else { v0 = (f32x4){0.f, 0.f, 0.f, 0.f}; v1 = v0; }
                    }
                    u32x4 w; w.x = pk2(v0[0], v0[1]); w.y = pk2(v0[2], v0[3]); w.z = pk2(v1[0], v1[1]); w.w = pk2(v1[2], v1[3]);
                    *(u32x4*)(dst + (size_t)row * 256 + bj * 128 + col0) = w; }
                asm volatile("" ::: "memory");
            }
    }
};
DI void row_stats(const float* STAT, int row, int fq, int lane, float& mu, float& rstd) {
    const f32x4 a = *(const f32x4*)(STAT + (size_t)row * 32 + fq * 8), b = *(const f32x4*)(STAT + (size_t)row * 32 + fq * 8 + 4);
    float s = (a[0] + a[2]) + (b[0] + b[2]), q = (a[1] + a[3]) + (b[1] + b[3]);
    s += bperm(s, lane ^ 16); q += bperm(q, lane ^ 16); s += bperm(s, lane ^ 32); q += bperm(q, lane ^ 32);
    mu = s * (1.0f / 1024.0f); rstd = __builtin_amdgcn_rsqf(fmaxf(q * (1.0f / 1024.0f) - mu * mu, 0.f) + EPS);
}
DI f32x4 bf4_to_f32(const u32x2 v) { return (f32x4){__uint_as_float(v.x << 16), __uint_as_float(v.x & 0xffff0000u), __uint_as_float(v.y << 16), __uint_as_float(v.y & 0xffff0000u)}; }
struct EpiResA {
    static constexpr bool PERM = true, AFTER_DRAIN = false;
    const float* res32; const bf16_t* res16; bf16_t* XBo; float* STAT;
    DI void operator()(const f32x4 (&acc)[2][2][4][2], const pg8::Unit& u, int wr, int wc, int fr, int fq) const {
        asm volatile("" : "+v"(fr), "+v"(fq));
        const int row0 = u.pm * 256 + wr * 64 + fr, col0 = u.pn * 256 + wc * 32 + 8 * fq, lane = fq * 16 + fr;
#pragma unroll
        for (int ai = 0; ai < 2; ++ai)
#pragma unroll
            for (int m = 0; m < 4; ++m) { const int row = row0 + ai * 128 + m * 16; const size_t off = (size_t)row * DMODEL + col0; float s = 0.f, q = 0.f;
#pragma unroll
                for (int bj = 0; bj < 2; ++bj) { float r[8];
                    if (res32) { const f32x4 r0 = *(const f32x4*)(res32 + off + bj * 128), r1 = *(const f32x4*)(res32 + off + bj * 128 + 4); r[0] = r0[0]; r[1] = r0[1]; r[2] = r0[2]; r[3] = r0[3]; r[4] = r1[0]; r[5] = r1[1]; r[6] = r1[2]; r[7] = r1[3]; }
                    else unpack8(*(const u32x4*)(res16 + off + bj * 128), r);
                    float o[8];
#pragma unroll
                    for (int k = 0; k < 8; ++k) { o[k] = r[k] * ALPHA + acc[ai][bj][m][k >> 2][k & 3]; s += o[k]; q += o[k] * o[k]; }
                    *(u32x4*)(XBo + off + bj * 128) = pack8(o); }
                s += bperm(s, lane ^ 16); q += bperm(q, lane ^ 16); s += bperm(s, lane ^ 32); q += bperm(q, lane ^ 32);
                if (fq == 0) *(f32x2*)(STAT + (size_t)row * 32 + (u.pn * 4 + wc) * 2) = (f32x2){s, q};
                if (m == 3) asm volatile("" ::: "memory"); }
    }
};
struct EpiResB {
    static constexpr bool PERM = true, AFTER_DRAIN = false;
    const bf16_t* XBin; bf16_t* XBout; float* out32; const float* STAT; const float* g; const float* b;
    DI void operator()(const f32x4 (&acc)[2][2][4][2], const pg8::Unit& u, int wr, int wc, int fr, int fq) const {
        asm volatile("" : "+v"(fr), "+v"(fq));
        const int row0 = u.pm * 256 + wr * 64 + fr, col0 = u.pn * 256 + wc * 32 + 8 * fq, lane = fq * 16 + fr;
#pragma unroll
        for (int ai = 0; ai < 2; ++ai)
#pragma unroll
            for (int m = 0; m < 4; ++m) { const int row = row0 + ai * 128 + m * 16; const size_t off = (size_t)row * DMODEL + col0; float mu, rstd; row_stats(STAT, row, fq, lane, mu, rstd);
#pragma unroll
                for (int bj = 0; bj < 2; ++bj) { float p[8]; unpack8(*(const u32x4*)(XBin + off + bj * 128), p);
                    const f32x4 g0 = *(const f32x4*)(g + col0 + bj * 128), g1 = *(const f32x4*)(g + col0 + bj * 128 + 4), b0 = *(const f32x4*)(b + col0 + bj * 128), b1 = *(const f32x4*)(b + col0 + bj * 128 + 4);
                    float o[8];
#pragma unroll
                    for (int k = 0; k < 8; ++k) { const float gg = k < 4 ? g0[k & 3] : g1[k & 3], bb = k < 4 ? b0[k & 3] : b1[k & 3]; const float x1 = (p[k] - mu) * rstd * gg + bb; o[k] = x1 * ALPHA + acc[ai][bj][m][k >> 2][k & 3]; }
                    if (out32) { *(f32x4*)(out32 + off + bj * 128) = (f32x4){o[0], o[1], o[2], o[3]}; *(f32x4*)(out32 + off + bj * 128 + 4) = (f32x4){o[4], o[5], o[6], o[7]}; }
                    else *(u32x4*)(XBout + off + bj * 128) = pack8(o); }
                if (m == 3) asm volatile("" ::: "memory"); }
    }
};
struct EpiSwiGLU {
    static constexpr bool PERM = true, AFTER_DRAIN = false;
    bf16_t* HID; const float* STAT; const float* C1; const float* C2;
    DI void operator()(const f32x4 (&acc)[2][2][4][2], const pg8::Unit& u, int wr, int wc, int fr, int fq) const {
        asm volatile("" : "+v"(fr), "+v"(fq));
        const int row0 = u.pm * 256 + wr * 64 + fr, col0 = u.pn * 128 + wc * 32 + 8 * fq, lane = fq * 16 + fr, cc = u.pn * 256 + wc * 32 + 8 * fq;
        f32x4 c1[2][2], c2[2][2];
#pragma unroll
        for (int bj = 0; bj < 2; ++bj)
#pragma unroll
            for (int n = 0; n < 2; ++n) { c1[bj][n] = *(const f32x4*)(C1 + cc + bj * 128 + n * 4); c2[bj][n] = *(const f32x4*)(C2 + cc + bj * 128 + n * 4); }
#pragma unroll
        for (int ai = 0; ai < 2; ++ai)
#pragma unroll
            for (int m = 0; m < 4; ++m) { const int row = row0 + ai * 128 + m * 16; float mu, rstd; row_stats(STAT, row, fq, lane, mu, rstd);
                const f32x4 g0 = (acc[ai][0][m][0] - c1[0][0] * mu) * rstd + c2[0][0], g1 = (acc[ai][0][m][1] - c1[0][1] * mu) * rstd + c2[0][1];
                const f32x4 u0 = (acc[ai][1][m][0] - c1[1][0] * mu) * rstd + c2[1][0], u1 = (acc[ai][1][m][1] - c1[1][1] * mu) * rstd + c2[1][1];
                u32x4 w; w.x = pk2(silu_f(g0[0]) * u0[0], silu_f(g0[1]) * u0[1]); w.y = pk2(silu_f(g0[2]) * u0[2], silu_f(g0[3]) * u0[3]);
                w.z = pk2(silu_f(g1[0]) * u1[0], silu_f(g1[1]) * u1[1]); w.w = pk2(silu_f(g1[2]) * u1[2], silu_f(g1[3]) * u1[3]);
                *(u32x4*)(HID + (size_t)row * DFF + col0) = w; }
    }
};

DI float wave_sum(float v, int lane) {
#pragma unroll
    for (int o = 1; o < 64; o <<= 1) v += bperm(v, lane ^ o);
    return v;
}
template <int MI, int NI>
DI void wgemm(f32x4 (&acc)[MI][NI], const LAS bf16_t* A, int pa, const LAS bf16_t* Bt, int pb, int K, int lane) {
    const int r = lane & 15, q = lane >> 4;
    const LAS bf16_t* ap = A + r * pa + q * 8; const LAS bf16_t* bp = Bt + r * pb + q * 8;
#pragma unroll 1
    for (int k = 0; k < K; k += 32) {
        bf16x8 a[MI], b[NI];
#pragma unroll
        for (int mi = 0; mi < MI; ++mi) a[mi] = *(const LAS bf16x8*)(ap + mi * 16 * pa + k);
#pragma unroll
        for (int ni = 0; ni < NI; ++ni) b[ni] = *(const LAS bf16x8*)(bp + ni * 16 * pb + k);
#pragma unroll
        for (int mi = 0; mi < MI; ++mi)
#pragma unroll
            for (int ni = 0; ni < NI; ++ni) acc[mi][ni] = __builtin_amdgcn_mfma_f32_16x16x32_bf16(a[mi], b[ni], acc[mi][ni], 0, 0, 0);
    }
}
template <int MI, int NI> DI void zero_acc(f32x4 (&acc)[MI][NI]) {
#pragma unroll
    for (int mi = 0; mi < MI; ++mi)
#pragma unroll
        for (int ni = 0; ni < NI; ++ni) acc[mi][ni] = (f32x4){0.f, 0.f, 0.f, 0.f};
}
DI void conv_load(const bf16_t* src, int s0, u32x4 (&raw)[7]) {
#pragma unroll
    for (int i = 0; i < 7; ++i) { const int s = s0 - 3 + i; raw[i] = (s >= 0) ? *(const u32x4*)(src + (size_t)s * HP) : (u32x4){0u, 0u, 0u, 0u}; }
}
template <bool SILU>
DI void conv_compute(const u32x4 (&raw)[7], const float* w, int C, const float* bias, float (&out)[4][8]) {
    float wv[4][8], bv[8], x[7][8];
#pragma unroll
    for (int j = 0; j < 4; ++j) { const f32x4 a = *(const f32x4*)(w + (size_t)j * C), b = *(const f32x4*)(w + (size_t)j * C + 4);
        wv[j][0] = a[0]; wv[j][1] = a[1]; wv[j][2] = a[2]; wv[j][3] = a[3]; wv[j][4] = b[0]; wv[j][5] = b[1]; wv[j][6] = b[2]; wv[j][7] = b[3]; }
    { const f32x4 a = *(const f32x4*)bias, b = *(const f32x4*)(bias + 4); bv[0] = a[0]; bv[1] = a[1]; bv[2] = a[2]; bv[3] = a[3]; bv[4] = b[0]; bv[5] = b[1]; bv[6] = b[2]; bv[7] = b[3]; }
#pragma unroll
    for (int i = 0; i < 7; ++i) unpack8(raw[i], x[i]);
#pragma unroll
    for (int t = 0; t < 4; ++t)
#pragma unroll
        for (int c = 0; c < 8; ++c) { float v = bv[c] + wv[0][c] * x[t][c] + wv[1][c] * x[t + 1][c] + wv[2][c] * x[t + 2][c] + wv[3][c] * x[t + 3][c]; out[t][c] = SILU ? silu_f(v) : v; }
}
template <bool SILU>
DI void conv8x4(const bf16_t* src, int s0, const float* w, int C, const float* bias, float (&out)[4][8]) { u32x4 raw[7]; conv_load(src, s0, raw); conv_compute<SILU>(raw, w, C, bias, out); }

struct LayerP {
    const float *g_q, *w_uq, *g_kv, *w_ukv, *ssd_cw, *ssd_cb, *ssd_dtb, *ssd_alog, *ssd_d, *ssd_ng, *ret_g, *ret_b, *lru_cw, *lru_cb, *lru_wa, *lru_ba, *lru_wx, *lru_bx, *lru_ap, *ln1g, *ln1b, *ln2g, *ln2b;
    const float *w_in, *w_out, *w_f1, *w_f2;
};
DI LayerP layer_params(KArgs ka, int l) {
    const Args a = *ka;
    LayerP p;
    p.w_in = a.in[2] + (size_t)l * DMODEL * NIN; p.g_q = a.in[3] + l * 256; p.w_uq = a.in[4] + (size_t)l * 256 * 192; p.g_kv = a.in[5] + l * 128; p.w_ukv = a.in[6] + (size_t)l * 128 * 384;
    p.ssd_cw = a.in[7] + l * 4 * 768; p.ssd_cb = a.in[8] + l * 768; p.ssd_dtb = a.in[9] + l * 4; p.ssd_alog = a.in[10] + l * 4; p.ssd_d = a.in[11] + l * 4; p.ssd_ng = a.in[12] + l * 256;
    p.ret_g = a.in[13] + l * 256; p.ret_b = a.in[14] + l * 256; p.lru_cw = a.in[15] + l * 4 * 256; p.lru_cb = a.in[16] + l * 256; p.lru_wa = a.in[17] + l * 16384; p.lru_ba = a.in[18] + l * 256;
    p.lru_wx = a.in[19] + l * 16384; p.lru_bx = a.in[20] + l * 256; p.lru_ap = a.in[21] + l * 256; p.w_out = a.in[22] + (size_t)l * 1024 * 1024; p.ln1g = a.in[23] + l * 1024; p.ln1b = a.in[24] + l * 1024;
    p.w_f1 = a.in[25] + (size_t)l * 1024 * 2 * DFF; p.w_f2 = a.in[26] + (size_t)l * DFF * 1024; p.ln2g = a.in[27] + l * 1024; p.ln2b = a.in[28] + l * 1024;
    return p;
}

template <class SrcCol>
DI void transpose_w(const float* W, int K, int Nsrc, bf16_t* WT, int Ndst, const float* gain, SrcCol sc, LAS float* scr, int gw, int NGW, int lane, int Kvalid = 1 << 30, const float* bias = nullptr, float* PART1 = nullptr, float* PART2 = nullptr) {
    const int nblk = Ndst / 32, nitems = (K / 64) * nblk;
    for (int it = gw; it < nitems; it += NGW) {
        const int kb = it / nblk, nb = it % nblk, k0 = 64 * kb, n0 = 32 * nb;
        const int src = sc(n0 + (lane & 31));
        float a1 = 0.f, a2 = 0.f;
#pragma unroll
        for (int i = 0; i < 32; ++i) { const int kk = 2 * i + (lane >> 5); float v = 0.f; if (src >= 0 && k0 + kk < Kvalid) { const float w = W[(size_t)(k0 + kk) * Nsrc + src]; v = gain ? w * gain[k0 + kk] : w; if (PART1) { a1 += bf2f(f2bf(v)); a2 += bias[k0 + kk] * w; } } scr[kk * 33 + (lane & 31)] = v; }
        if (PART1) { a1 += bperm(a1, lane ^ 32); a2 += bperm(a2, lane ^ 32); if (lane < 32) { PART1[(size_t)kb * Ndst + n0 + lane] = a1; PART2[(size_t)kb * Ndst + n0 + lane] = a2; } }
        asm volatile("s_waitcnt lgkmcnt(0)" ::: "memory");
        const int c = lane & 7;
#pragma unroll
        for (int j = 0; j < 4; ++j) { const int n = (lane >> 3) + 8 * j; const LAS float* s = scr + (8 * c) * 33 + n;
            u32x4 o; o.x = pk2(s[0 * 33], s[1 * 33]); o.y = pk2(s[2 * 33], s[3 * 33]); o.z = pk2(s[4 * 33], s[5 * 33]); o.w = pk2(s[6 * 33], s[7 * 33]);
            *(u32x4*)(WT + (size_t)(n0 + n) * K + k0 + 8 * c) = o; }
        asm volatile("s_waitcnt lgkmcnt(0)" ::: "memory");
    }
}
struct ScIn { DI int operator()(int n) const { return n < 1424 ? n : (n < 2960 ? n + 4 : (n < 2964 ? 1424 + (n - 2960) : -1)); } };
struct ScId { DI int operator()(int n) const { return n; } };
struct ScUq { DI int operator()(int n) const { const int h = n >> 6, e = n & 63; if (e < 32) return h * 48 + e; if (e >= 48) return -1; const int j = e - 32, fq = j >> 3, s = j & 7; return h * 48 + 32 + (s < 4 ? 4 * fq + s : 4 * fq + s + 4); } };
struct ScUkv { DI int operator()(int n) const { const int h = (n & 255) >> 6, e = n & 63; if (n < 256) return e < 32 ? h * 96 + e : -1; return h * 96 + 32 + e; } };
struct ScF1 { DI int operator()(int n) const { const int pn = n >> 8, x = n & 127; return (n & 128) ? DFF + 128 * pn + x : 128 * pn + x; } };

DI void convert_weights(const Args& a, int l, LAS unsigned char* lds, int wave, int lane) {
    const LayerP P = layer_params(kargs(), l);
    unsigned char* wb = a.ws + WS_W;
    LAS float* scr = (LAS float*)(lds + wave * 16384);
    const int gw0 = lbid() * 8 + wave, NGW = lgdim() * 8; int gw = gw0, base = 0;
#define NEXT_MAT(K_, N_) do { base = (base + ((K_) / 64) * ((N_) / 32)) % NGW; gw = gw0 - base; if (gw < 0) gw += NGW; } while (0)
    transpose_w(P.w_f1, 1024, 2 * DFF, (bf16_t*)(wb + W_F1), 2 * DFF, P.ln1g, ScF1(), scr, gw, NGW, lane, 1 << 30, P.ln1b, (float*)(wb + W_PART1), (float*)(wb + W_PART2));
    NEXT_MAT(1024, 2 * DFF);
    transpose_w(P.w_in, 1024, NIN, (bf16_t*)(wb + W_IN), HP, nullptr, ScIn(), scr, gw, NGW, lane);
    NEXT_MAT(1024, HP);
    transpose_w(P.w_f2, DFF, 1024, (bf16_t*)(wb + W_F2), 1024, nullptr, ScId(), scr, gw, NGW, lane);
    NEXT_MAT(DFF, 1024);
    transpose_w(P.w_out, 1024, 1024, (bf16_t*)(wb + W_OUT), 1024, nullptr, ScId(), scr, gw, NGW, lane);
    NEXT_MAT(1024, 1024);
    transpose_w(P.w_uq, 256, 192, (bf16_t*)(wb + W_UQ), 256, P.g_q, ScUq(), scr, gw, NGW, lane);
    NEXT_MAT(256, 256);
    transpose_w(P.w_ukv, 256, 384, (bf16_t*)(wb + W_UKV), 512, P.g_kv, ScUkv(), scr, gw, NGW, lane, 128);
    NEXT_MAT(256, 512);
    for (int m = 0; m < 8; ++m)
        { transpose_w((m < 4 ? P.lru_wa : P.lru_wx) + (m & 3) * 4096, 64, 64, (bf16_t*)(wb + W_LRU) + m * 4096, 64, nullptr, ScId(), scr, gw, NGW, lane); NEXT_MAT(64, 64); }
#undef NEXT_MAT
}

DI void ln_row(const float* xrow, const float* g, const float* b, float* orow, bf16_t* obf, int lane) {
    const f32x4* xr = (const f32x4*)xrow + lane;
    f32x4 v[4]; float s = 0.f;
#pragma unroll
    for (int j = 0; j < 4; ++j) { v[j] = xr[64 * j]; s += (v[j][0] + v[j][1]) + (v[j][2] + v[j][3]); }
    const float mean = wave_sum(s, lane) * (1.f / 1024.f); float s2 = 0.f;
#pragma unroll
    for (int j = 0; j < 4; ++j) { v[j] = v[j] - mean; s2 += (v[j][0] * v[j][0] + v[j][1] * v[j][1]) + (v[j][2] * v[j][2] + v[j][3] * v[j][3]); }
    const float rstd = 1.f / sqrtf(wave_sum(s2, lane) * (1.f / 1024.f) + EPS);
#pragma unroll
    for (int j = 0; j < 4; ++j) { const f32x4 gg = ((const f32x4*)g)[lane + 64 * j], bb = ((const f32x4*)b)[lane + 64 * j]; const f32x4 o = v[j] * rstd * gg + bb;
        ((f32x4*)orow)[lane + 64 * j] = o;
        if (obf) { u32x2 w; w.x = pk2(o[0], o[1]); w.y = pk2(o[2], o[3]); ((u32x2*)obf)[lane + 64 * j] = w; } }
}

DI void ln_rows2_bf16(bf16_t* xa, bf16_t* xb, const float* g, const float* b, int lane, bool two) {
    u32x4* xr[2] = {(u32x4*)xa, (u32x4*)xb}; float v[2][2][8]; float s[2] = {0.f, 0.f}, s2[2] = {0.f, 0.f}, mean[2], rstd[2];
    u32x4 raw[2][2];
#pragma unroll
    for (int r = 0; r < 2; ++r)
#pragma unroll
        for (int j = 0; j < 2; ++j) raw[r][j] = xr[r][lane + 64 * j];
#pragma unroll
    for (int r = 0; r < 2; ++r)
#pragma unroll
        for (int j = 0; j < 2; ++j) { unpack8(raw[r][j], v[r][j]);
#pragma unroll
            for (int k = 0; k < 8; ++k) s[r] += v[r][j][k]; }
#pragma unroll
    for (int o = 1; o < 64; o <<= 1) { s[0] += bperm(s[0], lane ^ o); s[1] += bperm(s[1], lane ^ o); }
#pragma unroll
    for (int r = 0; r < 2; ++r) { mean[r] = s[r] * (1.f / 1024.f);
#pragma unroll
        for (int j = 0; j < 2; ++j)
#pragma unroll
            for (int k = 0; k < 8; ++k) { v[r][j][k] -= mean[r]; s2[r] += v[r][j][k] * v[r][j][k]; } }
#pragma unroll
    for (int o = 1; o < 64; o <<= 1) { s2[0] += bperm(s2[0], lane ^ o); s2[1] += bperm(s2[1], lane ^ o); }
#pragma unroll
    for (int r = 0; r < 2; ++r) rstd[r] = 1.f / sqrtf(s2[r] * (1.f / 1024.f) + EPS);
#pragma unroll
    for (int j = 0; j < 2; ++j) { const int c0 = (lane + 64 * j) * 8; const f32x4 g0 = *(const f32x4*)(g + c0), g1 = *(const f32x4*)(g + c0 + 4), b0 = *(const f32x4*)(b + c0), b1 = *(const f32x4*)(b + c0 + 4);
#pragma unroll
        for (int r = 0; r < 2; ++r) { float o[8];
#pragma unroll
            for (int k = 0; k < 4; ++k) { o[k] = v[r][j][k] * rstd[r] * g0[k] + b0[k]; o[4 + k] = v[r][j][4 + k] * rstd[r] * g1[k] + b1[k]; }
            if (r == 0 || two) xr[r][lane + 64 * j] = pack8(o); } }
}
DI void ln_rows2_f32(float* xa, float* xb, const float* g, const float* b, int lane, bool two) {
    f32x4* xr[2] = {(f32x4*)xa, (f32x4*)xb}; f32x4 v[2][4]; float s[2] = {0.f, 0.f}, s2[2] = {0.f, 0.f}, mean[2], rstd[2];
#pragma unroll
    for (int r = 0; r < 2; ++r)
#pragma unroll
        for (int j = 0; j < 4; ++j) v[r][j] = xr[r][lane + 64 * j];
#pragma unroll
    for (int r = 0; r < 2; ++r)
#pragma unroll
        for (int j = 0; j < 4; ++j) s[r] += (v[r][j][0] + v[r][j][1]) + (v[r][j][2] + v[r][j][3]);
#pragma unroll
    for (int o = 1; o < 64; o <<= 1) { s[0] += bperm(s[0], lane ^ o); s[1] += bperm(s[1], lane ^ o); }
#pragma unroll
    for (int r = 0; r < 2; ++r) { mean[r] = s[r] * (1.f / 1024.f);
#pragma unroll
        for (int j = 0; j < 4; ++j) { v[r][j] = v[r][j] - mean[r]; s2[r] += (v[r][j][0] * v[r][j][0] + v[r][j][1] * v[r][j][1]) + (v[r][j][2] * v[r][j][2] + v[r][j][3] * v[r][j][3]); } }
#pragma unroll
    for (int o = 1; o < 64; o <<= 1) { s2[0] += bperm(s2[0], lane ^ o); s2[1] += bperm(s2[1], lane ^ o); }
#pragma unroll
    for (int r = 0; r < 2; ++r) rstd[r] = 1.f / sqrtf(s2[r] * (1.f / 1024.f) + EPS);
#pragma unroll
    for (int j = 0; j < 4; ++j) { const f32x4 gg = ((const f32x4*)g)[lane + 64 * j], bb = ((const f32x4*)b)[lane + 64 * j];
#pragma unroll
        for (int r = 0; r < 2; ++r) if (r == 0 || two) xr[r][lane + 64 * j] = v[r][j] * rstd[r] * gg + bb; }
}

constexpr int PT = 136;
DI void ssd_acs(const float* DT, const LayerP& P, int row0, int h, LAS float* acs, LAS float* dtl, int lane) {
    const float bias = P.ssd_dtb[h], A = -__expf(P.ssd_alog[h]);
    const float d0 = softplus_f(DT[(size_t)(row0 + 2 * lane) * 4 + h] + bias), d1 = softplus_f(DT[(size_t)(row0 + 2 * lane + 1) * 4 + h] + bias);
    const float a0 = d0 * A, a1 = d1 * A; float incl = a0 + a1;
#pragma unroll
    for (int o = 1; o < 64; o <<= 1) { const float t = bperm(incl, lane - o); if (lane >= o) incl += t; }
    const float excl = incl - (a0 + a1);
    acs[2 * lane] = excl + a0; acs[2 * lane + 1] = incl; dtl[2 * lane] = d0; dtl[2 * lane + 1] = d1;
}
DI void ssd_pass1(LAS unsigned char* lds, const Args& a, const LayerP& P, int unit, int wv) {
    const int tid = ltid(wv), lane = tid & 63, wave = wv;
    const int c = unit & (NCH - 1), b = unit >> 7, row0 = b * SEQ + c * 128;
    const bf16_t* Hb = (const bf16_t*)(a.ws + WS_H) + (size_t)b * SEQ * HP;
    LAS bf16_t* BT = (LAS bf16_t*)lds; LAS bf16_t* XT = (LAS bf16_t*)(lds + 69632); LAS float* acs = (LAS float*)(lds + 139264); LAS float* dtl = (LAS float*)(lds + 141312);
    const int cv = tid & 15, t0 = (tid >> 4) * 4;
    u32x4 rawX[2][7], rawB[2][7];
#pragma unroll
    for (int g = 0; g < 2; ++g) { conv_load(Hb + C_XBC + g * 128 + cv * 8, c * 128 + t0, rawX[g]); conv_load(Hb + C_XBC + 256 + g * 128 + cv * 8, c * 128 + t0, rawB[g]); }
    __syncthreads();
    if (wave < 4) ssd_acs((const float*)(a.ws + WS_DT), P, row0, wave, acs + wave * 128, dtl + wave * 128, lane);
    __syncthreads();
#pragma unroll
    for (int g = 0; g < 2; ++g) {
        { float o[4][8]; conv_compute<true>(rawX[g], P.ssd_cw + g * 128 + cv * 8, 768, P.ssd_cb + g * 128 + cv * 8, o);
          const int h = 2 * g + (cv >> 3); const float ae = acs[h * 128 + 127]; float w[4];
#pragma unroll
          for (int t = 0; t < 4; ++t) w[t] = __expf(ae - acs[h * 128 + t0 + t]) * dtl[h * 128 + t0 + t];
#pragma unroll
          for (int k = 0; k < 8; ++k) { u32x2 v; v.x = pk2(o[0][k] * w[0], o[1][k] * w[1]); v.y = pk2(o[2][k] * w[2], o[3][k] * w[3]); *(LAS u32x2*)(XT + (h * 64 + (cv & 7) * 8 + k) * PT + t0) = v; } }
        { float o[4][8]; conv_compute<true>(rawB[g], P.ssd_cw + 256 + g * 128 + cv * 8, 768, P.ssd_cb + 256 + g * 128 + cv * 8, o);
#pragma unroll
          for (int k = 0; k < 8; ++k) { u32x2 v; v.x = pk2(o[0][k], o[1][k]); v.y = pk2(o[2][k], o[3][k]); *(LAS u32x2*)(BT + (g * 128 + cv * 8 + k) * PT + t0) = v; } }
    }
    __syncthreads();
    const int h = wave >> 1, nb = (wave & 1) * 64, r = lane & 15, q = lane >> 4;
    f32x4 acc[4][4]; zero_acc(acc);
    wgemm<4, 4>(acc, BT + ((h >> 1) * 128 + nb) * PT, PT, XT + h * 64 * PT, PT, 128, lane);
    float* ST = (float*)((unsigned char*)a.out + DO_ST) + ((size_t)((b * NCH + c) * 4 + h)) * 8192;
#pragma unroll
    for (int mi = 0; mi < 4; ++mi)
#pragma unroll
        for (int ni = 0; ni < 4; ++ni) *(f32x4*)(ST + (ni * 16 + r) * 128 + nb + mi * 16 + 4 * q) = acc[mi][ni];
    if (tid < 4) ((float*)(a.ws + WS_SDEC))[(b * NCH + c) * 4 + tid] = __expf(acs[tid * 128 + 127]);
}
DI void ssd_pass2(LAS unsigned char* lds, const Args& a, const LayerP& P, int unit, int wv) {
    const int wave = wv;
    const int c = unit & (NCH - 1), b = unit >> 7, row0 = b * SEQ + c * 128;
    const bf16_t* Hg = (const bf16_t*)(a.ws + WS_H);
    const bf16_t* Hb = Hg + (size_t)b * SEQ * HP;
    LAS bf16_t* Cm = (LAS bf16_t*)lds; LAS bf16_t* R1 = (LAS bf16_t*)(lds + 34816); LAS bf16_t* Mw = (LAS bf16_t*)(lds + 69632 + wave * 8704);
    LAS float* acs = (LAS float*)(lds + 139264); LAS float* dtl = (LAS float*)(lds + 140288); LAS float* rowss = (LAS float*)(lds + 141312);
    const int hh = wave >> 2, lr = (wave & 3) * 32;
    float* YT = (float*)(a.ws + WS_YT);
    u32x4 rawC[7]; { const int t_ = ltid(wv); conv_load(Hb + C_XBC + 512 + (t_ & 15) * 8, c * 128 + (t_ >> 4) * 4, rawC); }
#pragma unroll 1
    for (int g = 0; g < 2; ++g) {
        const int tid = ltid(wv), lane = tid & 63, cv = tid & 15, t0 = (tid >> 4) * 4, r = lane & 15, q = lane >> 4;
        __syncthreads();
        if (wave < 2) ssd_acs((const float*)(a.ws + WS_DT), P, row0, 2 * g + wave, acs + wave * 128, dtl + wave * 128, lane);
        { float o[4][8]; conv_compute<true>(rawC, P.ssd_cw + 512 + g * 128 + cv * 8, 768, P.ssd_cb + 512 + g * 128 + cv * 8, o);
#pragma unroll
          for (int t = 0; t < 4; ++t) *(LAS u32x4*)(Cm + (t0 + t) * PT + cv * 8) = pack8(o[t]); }
        { const float* ST = (const float*)((const unsigned char*)a.out + DO_ST) + ((size_t)((b * NCH + c) * 4 + 2 * g)) * 8192;
#pragma unroll
          for (int i = 0; i < 8; ++i) { const int e4 = (i * 512 + tid) * 4; const f32x4 v = *(const f32x4*)(ST + e4); u32x2 w; w.x = pk2(v[0], v[1]); w.y = pk2(v[2], v[3]);
              *(LAS u32x2*)(R1 + (e4 >> 7) * PT + (e4 & 127)) = w; } }
        u32x4 rawB[7]; conv_load(Hb + C_XBC + 256 + g * 128 + cv * 8, c * 128 + t0, rawB);
        __syncthreads();
        f32x4 acc[4][2]; zero_acc(acc);
        wgemm<4, 2>(acc, R1 + hh * 64 * PT, PT, Cm + lr * PT, PT, 128, lane);
#pragma unroll
        for (int ni = 0; ni < 2; ++ni) { const float e = __expf(acs[hh * 128 + lr + ni * 16 + r]);
#pragma unroll
            for (int mi = 0; mi < 4; ++mi) acc[mi][ni] = acc[mi][ni] * e; }
        __syncthreads();
        { float o[4][8]; conv_compute<true>(rawB, P.ssd_cw + 256 + g * 128 + cv * 8, 768, P.ssd_cb + 256 + g * 128 + cv * 8, o);
#pragma unroll
          for (int t = 0; t < 4; ++t) *(LAS u32x4*)(R1 + (t0 + t) * PT + cv * 8) = pack8(o[t]); }
        u32x4 rawX[7]; conv_load(Hb + C_XBC + g * 128 + cv * 8, c * 128 + t0, rawX);
        __syncthreads();
#pragma unroll 1
        for (int sh = 0; sh < 2; ++sh) { f32x4 gacc[2][4]; zero_acc(gacc);
          wgemm<2, 4>(gacc, Cm + lr * PT, PT, R1 + sh * 64 * PT, PT, 128, lane);
#pragma unroll
          for (int mi = 0; mi < 2; ++mi)
#pragma unroll
              for (int j = 0; j < 4; ++j) { const int ll = mi * 16 + 4 * q + j, l = lr + ll; const float al = acs[hh * 128 + l];
#pragma unroll
                  for (int ni = 0; ni < 4; ++ni) { const int s = sh * 64 + ni * 16 + r; const float v = (s <= l) ? gacc[mi][ni][j] * __expf(al - acs[hh * 128 + s]) * dtl[hh * 128 + s] : 0.f; Mw[ll * PT + s] = f2bf(v); } } }
        __syncthreads();
        { float o[4][8]; conv_compute<true>(rawX, P.ssd_cw + g * 128 + cv * 8, 768, P.ssd_cb + g * 128 + cv * 8, o);
#pragma unroll
          for (int k = 0; k < 8; ++k) { u32x2 v; v.x = pk2(o[0][k], o[1][k]); v.y = pk2(o[2][k], o[3][k]); *(LAS u32x2*)(R1 + ((cv >> 3) * 64 + (cv & 7) * 8 + k) * PT + t0) = v; } }
        __syncthreads();
        const int h = 2 * g + hh; const float dsk = P.ssd_d[h];
        if (g == 0) conv_load(Hb + C_XBC + 512 + 128 + cv * 8, c * 128 + t0, rawC);
        u32x2 zr[2][4];
#pragma unroll
        for (int ni = 0; ni < 2; ++ni)
#pragma unroll
            for (int mi = 0; mi < 4; ++mi) zr[ni][mi] = *(const u32x2*)(Hg + (size_t)(row0 + lr + ni * 16 + r) * HP + C_Z + h * 64 + mi * 16 + 4 * q);
        wgemm<4, 2>(acc, R1 + hh * 64 * PT, PT, Mw, PT, 128, lane);
#pragma unroll
        for (int ni = 0; ni < 2; ++ni) { const int l = lr + ni * 16 + r; float ss = 0.f;
#pragma unroll
            for (int mi = 0; mi < 4; ++mi) { const int p0 = mi * 16 + 4 * q; const f32x4 z = bf4_to_f32(zr[ni][mi]); f32x4 y;
#pragma unroll
                for (int j = 0; j < 4; ++j) { const float xs = bf2f(R1[(hh * 64 + p0 + j) * PT + l]); y[j] = (acc[mi][ni][j] + xs * dsk) * silu_f(z[j]); ss += y[j] * y[j]; }
                *(f32x4*)(YT + (size_t)(row0 + l) * 256 + h * 64 + p0) = y; }
            ss += bperm(ss, lane ^ 16); ss += bperm(ss, lane ^ 32);
            if (q == 0) rowss[h * 128 + l] = ss; }
    }
    __syncthreads();
    bf16_t* Y = (bf16_t*)(a.ws + WS_Y);
#pragma unroll 1
    for (int g = 0; g < 2; ++g) { const int lane = ltid(wv) & 63, r = lane & 15, q = lane >> 4, h = 2 * g + hh;
#pragma unroll
        for (int ni = 0; ni < 2; ++ni) { const int l = lr + ni * 16 + r;
            const float rs = __builtin_amdgcn_rsqf(((rowss[l] + rowss[128 + l]) + (rowss[256 + l] + rowss[384 + l])) * (1.0f / 256.0f) + EPS);
#pragma unroll
            for (int mi = 0; mi < 4; ++mi) { const int p0 = mi * 16 + 4 * q; const f32x4 y = *(const f32x4*)(YT + (size_t)(row0 + l) * 256 + h * 64 + p0), ng = *(const f32x4*)(P.ssd_ng + h * 64 + p0);
                u32x2 w; w.x = pk2(y[0] * rs * ng[0], y[1] * rs * ng[1]); w.y = pk2(y[2] * rs * ng[2], y[3] * rs * ng[3]);
                *(u32x2*)(Y + (size_t)(row0 + l) * DMODEL + 256 + h * 64 + p0) = w; } } }
}

constexpr int PQ = 72;
DI float ret_lg(int h) { return log1pf(-exp2f(-5.0f - (float)h)); }
template <int MODE>
DI void ret_stage(const Args& a, int row0, int h, float lg, LAS bf16_t* Qs, LAS bf16_t* Ks, LAS bf16_t* VT, LAS bf16_t* KT, int tid) {
    const bf16_t* Hg = (const bf16_t*)(a.ws + WS_H); const float* tab = (const float*)(a.ws + WS_ROPE64);
    const int t = tid >> 2, part = tid & 3, row = row0 + t; const bf16_t* hr = Hg + (size_t)row * HP;
    float cs[16]; { const f32x4* tp = (const f32x4*)(tab + (size_t)row * 64 + part * 16);
#pragma unroll
        for (int i = 0; i < 4; ++i) { const f32x4 v = tp[i]; cs[4 * i] = v[0]; cs[4 * i + 1] = v[1]; cs[4 * i + 2] = v[2]; cs[4 * i + 3] = v[3]; } }
    { float k1[8], k2[8], o1[8], o2[8]; unpack8(*(const u32x4*)(hr + C_RK + h * 64 + part * 8), k1); unpack8(*(const u32x4*)(hr + C_RK + h * 64 + 32 + part * 8), k2);
      const float sc = 0.125f * (MODE == 0 ? __expf(lg * (float)(127 - t)) : 1.0f);
#pragma unroll
      for (int i = 0; i < 8; ++i) { o1[i] = (k1[i] * cs[2 * i] - k2[i] * cs[2 * i + 1]) * sc; o2[i] = (k1[i] * cs[2 * i + 1] + k2[i] * cs[2 * i]) * sc; }
      if (MODE == 0) {
#pragma unroll
          for (int i = 0; i < 8; ++i) { KT[(part * 8 + i) * PT + t] = f2bf(o1[i]); KT[(32 + part * 8 + i) * PT + t] = f2bf(o2[i]); } }
      else { *(LAS u32x4*)(Ks + t * PQ + part * 8) = pack8(o1); *(LAS u32x4*)(Ks + t * PQ + 32 + part * 8) = pack8(o2); } }
    if (MODE == 1) { float q1[8], q2[8], o1[8], o2[8]; unpack8(*(const u32x4*)(hr + C_RQ + h * 64 + part * 8), q1); unpack8(*(const u32x4*)(hr + C_RQ + h * 64 + 32 + part * 8), q2);
#pragma unroll
      for (int i = 0; i < 8; ++i) { o1[i] = q1[i] * cs[2 * i] - q2[i] * cs[2 * i + 1]; o2[i] = q1[i] * cs[2 * i + 1] + q2[i] * cs[2 * i]; }
      *(LAS u32x4*)(Qs + t * PQ + part * 8) = pack8(o1); *(LAS u32x4*)(Qs + t * PQ + 32 + part * 8) = pack8(o2); }
    { float v[8]; unpack8(*(const u32x4*)(hr + C_RV + h * 64 + part * 16), v);
#pragma unroll
      for (int i = 0; i < 8; ++i) VT[(part * 16 + i) * PT + t] = f2bf(v[i]);
      unpack8(*(const u32x4*)(hr + C_RV + h * 64 + part * 16 + 8), v);
#pragma unroll
      for (int i = 0; i < 8; ++i) VT[(part * 16 + 8 + i) * PT + t] = f2bf(v[i]); }
}
struct RetRaw { f32x4 cs[4]; u32x4 k1, k2, q1, q2, v0, v1; f32x4 rs[2]; };
DI void ret_load(const Args& a, int row0, int h, int bc, int tid, RetRaw& R) {
    const bf16_t* Hg = (const bf16_t*)(a.ws + WS_H); const float* tab = (const float*)(a.ws + WS_ROPE64);
    const int t = tid >> 2, part = tid & 3, row = row0 + t; const bf16_t* hr = Hg + (size_t)row * HP;
    const f32x4* tp = (const f32x4*)(tab + (size_t)row * 64 + part * 16);
#pragma unroll
    for (int i = 0; i < 4; ++i) R.cs[i] = tp[i];
    R.k1 = *(const u32x4*)(hr + C_RK + h * 64 + part * 8); R.k2 = *(const u32x4*)(hr + C_RK + h * 64 + 32 + part * 8);
    R.q1 = *(const u32x4*)(hr + C_RQ + h * 64 + part * 8); R.q2 = *(const u32x4*)(hr + C_RQ + h * 64 + 32 + part * 8);
    R.v0 = *(const u32x4*)(hr + C_RV + h * 64 + part * 16); R.v1 = *(const u32x4*)(hr + C_RV + h * 64 + part * 16 + 8);
    const float* RS = (const float*)((const unsigned char*)a.out + DO_RS) + ((size_t)(bc * 4 + h)) * 4096;
#pragma unroll
    for (int i = 0; i < 2; ++i) R.rs[i] = *(const f32x4*)(RS + (i * 512 + tid) * 4);
}
DI void ret_write(const RetRaw& R, LAS bf16_t* Qs, LAS bf16_t* Ks, LAS bf16_t* VT, LAS bf16_t* STt, int tid) {
    const int t = tid >> 2, part = tid & 3;
    float cs[16];
#pragma unroll
    for (int i = 0; i < 4; ++i) { cs[4 * i] = R.cs[i][0]; cs[4 * i + 1] = R.cs[i][1]; cs[4 * i + 2] = R.cs[i][2]; cs[4 * i + 3] = R.cs[i][3]; }
    { float k1[8], k2[8], o1[8], o2[8]; unpack8(R.k1, k1); unpack8(R.k2, k2);
#pragma unroll
      for (int i = 0; i < 8; ++i) { o1[i] = (k1[i] * cs[2 * i] - k2[i] * cs[2 * i + 1]) * 0.125f; o2[i] = (k1[i] * cs[2 * i + 1] + k2[i] * cs[2 * i]) * 0.125f; }
      *(LAS u32x4*)(Ks + t * PQ + part * 8) = pack8(o1); *(LAS u32x4*)(Ks + t * PQ + 32 + part * 8) = pack8(o2); }
    { float q1[8], q2[8], o1[8], o2[8]; unpack8(R.q1, q1); unpack8(R.q2, q2);
#pragma unroll
      for (int i = 0; i < 8; ++i) { o1[i] = q1[i] * cs[2 * i] - q2[i] * cs[2 * i + 1]; o2[i] = q1[i] * cs[2 * i + 1] + q2[i] * cs[2 * i]; }
      *(LAS u32x4*)(Qs + t * PQ + part * 8) = pack8(o1); *(LAS u32x4*)(Qs + t * PQ + 32 + part * 8) = pack8(o2); }
    { float v[8]; unpack8(R.v0, v);
#pragma unroll
      for (int i = 0; i < 8; ++i) VT[(part * 16 + i) * PT + t] = f2bf(v[i]);
      unpack8(R.v1, v);
#pragma unroll
      for (int i = 0; i < 8; ++i) VT[(part * 16 + 8 + i) * PT + t] = f2bf(v[i]); }
#pragma unroll
    for (int i = 0; i < 2; ++i) { const int e4 = (i * 512 + tid) * 4; const f32x4 v = R.rs[i]; u32x2 w; w.x = pk2(v[0], v[1]); w.y = pk2(v[2], v[3]); *(LAS u32x2*)(STt + (e4 >> 6) * PQ + (e4 & 63)) = w; }
}
DI void ret_pass1(LAS unsigned char* lds, const Args& a, int unit, int wv) {
    const int wave = wv, c = unit & (NCH - 1), b = unit >> 7, row0 = b * SEQ + c * 128;
    const int tid = ltid(wv), lane = tid & 63, r = lane & 15, q = lane >> 4;
    __syncthreads();
#pragma unroll
    for (int h = 0; h < 4; ++h) ret_stage<0>(a, row0, h, ret_lg(h), nullptr, nullptr, (LAS bf16_t*)(lds + h * 34816), (LAS bf16_t*)(lds + h * 34816 + 17408), tid);
    __syncthreads();
    const int h = wave >> 1, e0 = (wave & 1) * 32;
    LAS bf16_t* VT = (LAS bf16_t*)(lds + h * 34816); LAS bf16_t* KT = (LAS bf16_t*)(lds + h * 34816 + 17408);
    f32x4 acc[4][2]; zero_acc(acc);
    wgemm<4, 2>(acc, KT, PT, VT + e0 * PT, PT, 128, lane);
    float* RS = (float*)((unsigned char*)a.out + DO_RS) + ((size_t)((b * NCH + c) * 4 + h)) * 4096;
#pragma unroll
    for (int mi = 0; mi < 4; ++mi)
#pragma unroll
        for (int ni = 0; ni < 2; ++ni) *(f32x4*)(RS + (e0 + ni * 16 + r) * 64 + mi * 16 + 4 * q) = acc[mi][ni];
}
DI void ret_pass2(LAS unsigned char* lds, const Args& a, const LayerP& P, int unit, int wv) {
    const int wave = wv, c = unit & (NCH - 1), b = unit >> 7, row0 = b * SEQ + c * 128, i0 = wave * 16;
    LAS bf16_t* Qs = (LAS bf16_t*)lds; LAS bf16_t* Ks = (LAS bf16_t*)(lds + 18432); LAS bf16_t* VT = (LAS bf16_t*)(lds + 36864); LAS bf16_t* STt = (LAS bf16_t*)(lds + 54272);
    LAS bf16_t* Pw = (LAS bf16_t*)(lds + 63488 + wave * 4352);
    const bf16_t* Hg = (const bf16_t*)(a.ws + WS_H); bf16_t* Y = (bf16_t*)(a.ws + WS_Y);
    RetRaw R; ret_load(a, row0, 0, b * NCH + c, ltid(wv), R);
#pragma unroll 1
    for (int h = 0; h < 4; ++h) {
        const int tid = ltid(wv), lane = tid & 63, r = lane & 15, q = lane >> 4;
        const float lg = ret_lg(h);
        __syncthreads();
        ret_write(R, Qs, Ks, VT, STt, tid);
        if (h < 3) ret_load(a, row0, h + 1, b * NCH + c, tid, R);
        __syncthreads();
        { f32x4 sacc[1][8]; zero_acc(sacc);
          wgemm<1, 8>(sacc, Qs + i0 * PQ, PQ, Ks, PQ, 64, lane);
#pragma unroll
          for (int j = 0; j < 4; ++j) { const int ii = 4 * q + j, i = i0 + ii;
#pragma unroll
              for (int ni = 0; ni < 8; ++ni) { const int jj = ni * 16 + r; const float v = (i >= jj) ? sacc[0][ni][j] * __expf(lg * (float)(i - jj)) : 0.f; Pw[ii * PT + jj] = f2bf(v); } } }
        __syncthreads();
        u32x2 gr[4];
#pragma unroll
        for (int mi = 0; mi < 4; ++mi) gr[mi] = *(const u32x2*)(Hg + (size_t)(row0 + i0 + r) * HP + C_RG + h * 64 + mi * 16 + 4 * q);
        f32x4 oacc[4][1], cacc[4][1]; zero_acc(oacc); zero_acc(cacc);
        wgemm<4, 1>(oacc, VT, PT, Pw, PT, 128, lane);
        wgemm<4, 1>(cacc, STt, PQ, Qs + i0 * PQ, PQ, 64, lane);
        { const int i = i0 + r; const float qd = __expf(lg * (float)(i + 1)); f32x4 o[4]; float s = 0.f;
#pragma unroll
          for (int mi = 0; mi < 4; ++mi) { o[mi] = oacc[mi][0] + cacc[mi][0] * qd; s += (o[mi][0] + o[mi][1]) + (o[mi][2] + o[mi][3]); }
          s += bperm(s, lane ^ 16); s += bperm(s, lane ^ 32);
          const float mu = s * (1.0f / 64.0f); float v2 = 0.f;
#pragma unroll
          for (int mi = 0; mi < 4; ++mi) { o[mi] = o[mi] - mu; v2 += (o[mi][0] * o[mi][0] + o[mi][1] * o[mi][1]) + (o[mi][2] * o[mi][2] + o[mi][3] * o[mi][3]); }
          v2 += bperm(v2, lane ^ 16); v2 += bperm(v2, lane ^ 32);
          const float rs = __builtin_amdgcn_rsqf(v2 * (1.0f / 64.0f) + EPS);
#pragma unroll
          for (int mi = 0; mi < 4; ++mi) { const int ch = h * 64 + mi * 16 + 4 * q; const f32x4 gt = bf4_to_f32(gr[mi]);
              const f32x4 gg = *(const f32x4*)(P.ret_g + ch), bb = *(const f32x4*)(P.ret_b + ch); const f32x4 y = o[mi] * rs * gg + bb;
              u32x2 w; w.x = pk2(silu_f(gt[0]) * y[0], silu_f(gt[1]) * y[1]); w.y = pk2(silu_f(gt[2]) * y[2], silu_f(gt[3]) * y[3]);
              *(u32x2*)(Y + (size_t)(row0 + i) * DMODEL + 512 + ch) = w; } }
    }
}

constexpr int PU = 264;
template <bool OUT>
DI void lru_sweep(LAS bf16_t* U, LAS float* SUM, const Args& a, const LayerP& P, int row0, int wv, const float* LC, f32x2* LSWc) {
    const int wave = wv, l0 = wave * 16;
    const bf16_t* LWT = (const bf16_t*)(a.ws + WS_W + W_LRU); const bf16_t* Hg = (const bf16_t*)(a.ws + WS_H); bf16_t* Y = (bf16_t*)(a.ws + WS_Y);
#pragma unroll 1
    for (int g = 0; g < 4; ++g) {
        const int lane = ltid(wv) & 63, r = lane & 15, q = lane >> 4;
        bf16x8 af[2];
#pragma unroll
        for (int ks = 0; ks < 2; ++ks) af[ks] = *(const LAS bf16x8*)(U + (l0 + r) * PU + g * 64 + ks * 32 + q * 8);
#pragma unroll
        for (int ni = 0; ni < 4; ++ni) { f32x4 aa1 = (f32x4){0.f, 0.f, 0.f, 0.f}, ax1 = aa1;
#pragma unroll
            for (int ks = 0; ks < 2; ++ks) { const bf16x8 wa = *(const bf16x8*)(LWT + ((size_t)(g * 64 + ni * 16 + r)) * 64 + ks * 32 + q * 8), wx = *(const bf16x8*)(LWT + ((size_t)((4 + g) * 64 + ni * 16 + r)) * 64 + ks * 32 + q * 8);
                aa1 = __builtin_amdgcn_mfma_f32_16x16x32_bf16(af[ks], wa, aa1, 0, 0, 0); ax1 = __builtin_amdgcn_mfma_f32_16x16x32_bf16(af[ks], wx, ax1, 0, 0, 0); }
            const int ch = g * 64 + ni * 16 + r; const float ba = P.lru_ba[ch], bx = P.lru_bx[ch], c8 = -8.0f * softplus_f(-P.lru_ap[ch]);
            float Pi[4], Ei[4], Pc = 1.f, Ec = 0.f;
#pragma unroll
            for (int j = 0; j < 4; ++j) { const float rg = sigmoid_f(aa1[j] + ba), ig = sigmoid_f(ax1[j] + bx); const float la = c8 * rg, av = __expf(la);
                const float u = bf2f(U[(l0 + 4 * q + j) * PU + ch]); const float inp = __builtin_amdgcn_sqrtf(one_minus_exp(2.0f * la)) * (ig * u);
                if (!OUT) ((unsigned*)(a.ws + WS_LA))[(size_t)(row0 + l0 + 4 * q + j) * 256 + ch] = pk2(one_minus_exp(la), inp);
                Ec = av * Ec + inp; Pc = Pc * av; Pi[j] = Pc; Ei[j] = Ec; }
            float Pp = 1.f, Ep = 0.f;
#pragma unroll
            for (int qq = 0; qq < 3; ++qq) { const float Pq = bperm(Pc, r + 16 * qq), Eq = bperm(Ec, r + 16 * qq); if (qq < q) { Ep = Pq * Ep + Eq; Pp = Pp * Pq; } }
#pragma unroll
            for (int j = 0; j < 4; ++j) { Ei[j] = Pi[j] * Ep + Ei[j]; Pi[j] = Pp * Pi[j]; }
            if (!OUT) { if (q == 3) { SUM[(wave * 256 + ch) * 2] = Pi[3]; SUM[(wave * 256 + ch) * 2 + 1] = Ei[3]; LSWc[wave * 256 + ch] = (f32x2){Pi[3], Ei[3]}; } }
            else { float hp = LC[ch];
                { f32x2 t[7];
#pragma unroll
                  for (int w = 0; w < 7; ++w) if (w < wave) t[w] = LSWc[w * 256 + ch];
#pragma unroll
                  for (int w = 0; w < 7; ++w) if (w < wave) hp = t[w][0] * hp + t[w][1]; }
#pragma unroll
                for (int j = 0; j < 4; ++j) { const int row = row0 + l0 + 4 * q + j; const float hv = Pi[j] * hp + Ei[j]; const float gt = bf2f(Hg[(size_t)row * HP + C_LG + ch]);
                    Y[(size_t)row * DMODEL + 768 + ch] = f2bf(hv * gelu_tanh_f(gt)); } }
        }
    }
}
template <int MODE>
DI void lru_chunk(LAS unsigned char* lds, const Args& a, const LayerP& P, int unit, int wv) {
    const int tid = ltid(wv), c = unit & (NCH - 1), b = unit >> 7, row0 = b * SEQ + c * 128;
    LAS bf16_t* U = (LAS bf16_t*)lds; LAS float* SUM = (LAS float*)(lds + 67584);
    const bf16_t* Hb = (const bf16_t*)(a.ws + WS_H) + (size_t)b * SEQ * HP;
    __syncthreads();
    { const int cv = tid & 31, run = tid >> 5; u32x4 raw[2][7];
#pragma unroll
      for (int hf = 0; hf < 2; ++hf) conv_load(Hb + C_LX + cv * 8, c * 128 + run * 8 + hf * 4, raw[hf]);
#pragma unroll
      for (int hf = 0; hf < 2; ++hf) { const int t0 = run * 8 + hf * 4; float o[4][8]; conv_compute<false>(raw[hf], P.lru_cw + cv * 8, 256, P.lru_cb + cv * 8, o);
#pragma unroll
          for (int t = 0; t < 4; ++t) *(LAS u32x4*)(U + (t0 + t) * PU + cv * 8) = pack8(o[t]); } }
    __syncthreads();
    f32x2* LSWc = (f32x2*)(a.ws + WS_LSW) + (size_t)(b * NCH + c) * 8 * 256;
    if (MODE == 0) {
        lru_sweep<false>(U, SUM, a, P, row0, wv, nullptr, LSWc);
        __syncthreads();
        if (tid < 256) { float Pc = 1.f, Ec = 0.f;
#pragma unroll
            for (int w = 0; w < 8; ++w) { const float Pw = SUM[(w * 256 + tid) * 2], Ew = SUM[(w * 256 + tid) * 2 + 1]; Ec = Pw * Ec + Ew; Pc = Pc * Pw; }
            float* LS = (float*)(a.ws + WS_LSUM) + ((size_t)(b * NCH + c) * 256 + tid) * 2; LS[0] = Pc; LS[1] = Ec; }
    } else {
        lru_sweep<true>(U, SUM, a, P, row0, wv, (const float*)(a.ws + WS_LCARRY) + (size_t)(b * NCH + c) * 256, LSWc);
    }
}

DI void lru_out(const Args& a, int unit, int wv) {
    const int tid = ltid(wv), c = unit & (NCH - 1), b = unit >> 7, row0 = b * SEQ + c * 128, ch = (tid & 63) * 4, k = wv;
    const u32x4* LAI = (const u32x4*)(a.ws + WS_LA); const bf16_t* Hg = (const bf16_t*)(a.ws + WS_H); bf16_t* Y = (bf16_t*)(a.ws + WS_Y);
    const f32x4* LSWc = (const f32x4*)((const f32x2*)(a.ws + WS_LSW) + (size_t)(b * NCH + c) * 8 * 256);
    f32x4 h = *(const f32x4*)((const float*)(a.ws + WS_LCARRY) + (size_t)(b * NCH + c) * 256 + ch);
    f32x4 t0[7], t1[7];
#pragma unroll
    for (int w = 0; w < 7; ++w) if (w < k) { t0[w] = LSWc[(w * 256 + ch) / 2]; t1[w] = LSWc[(w * 256 + ch) / 2 + 1]; }
#pragma unroll
    for (int w = 0; w < 7; ++w) if (w < k) { h[0] = t0[w][0] * h[0] + t0[w][1]; h[1] = t0[w][2] * h[1] + t0[w][3]; h[2] = t1[w][0] * h[2] + t1[w][1]; h[3] = t1[w][2] * h[3] + t1[w][3]; }
    u32x4 pr[16]; u32x2 gt[16];
#pragma unroll
    for (int t = 0; t < 16; ++t) { const size_t row = (size_t)(row0 + 16 * k + t); pr[t] = LAI[(row * 256 + ch) / 4]; gt[t] = *(const u32x2*)(Hg + row * HP + C_LG + ch); }
#pragma unroll
    for (int t = 0; t < 16; ++t) { const unsigned w4[4] = {pr[t].x, pr[t].y, pr[t].z, pr[t].w};
#pragma unroll
        for (int e = 0; e < 4; ++e) { const float oma = __uint_as_float(w4[e] << 16), inp = __uint_as_float(w4[e] & 0xffff0000u); h[e] = (h[e] - oma * h[e]) + inp; }
        const f32x4 g = bf4_to_f32(gt[t]); u32x2 w; w.x = pk2(h[0] * gelu_tanh_f(g[0]), h[1] * gelu_tanh_f(g[1])); w.y = pk2(h[2] * gelu_tanh_f(g[2]), h[3] * gelu_tanh_f(g[3]));
        *(u32x2*)(Y + (size_t)(row0 + 16 * k + t) * DMODEL + 768 + ch) = w; }
}

DI void chunk_scans(const Args& a, int tid) {
    const int gt = lbid() * 512 + tid, NT = lgdim() * 512;
    for (int n = gt; n < 2 * DFF; n += NT) { const float* p1 = (const float*)(a.ws + WS_W + W_PART1) + n; const float* p2 = (const float*)(a.ws + WS_W + W_PART2) + n; float s1 = 0.f, s2 = 0.f;
#pragma unroll
        for (int kb = 0; kb < 16; ++kb) { s1 += p1[(size_t)kb * 2 * DFF]; s2 += p2[(size_t)kb * 2 * DFF]; }
        ((float*)(a.ws + WS_W + W_C1F))[n] = s1; ((float*)(a.ws + WS_W + W_C2F))[n] = s2; }
    for (int idx = gt; idx < 65536 + 32768 + 512; idx += NT) {
        if (idx < 65536) { const int b = idx >> 15, rem = idx & 32767, h = rem >> 13;
            float* p = (float*)((unsigned char*)a.out + DO_ST) + (size_t)b * NCH * 32768 + rem; const float* dec = (const float*)(a.ws + WS_SDEC) + b * NCH * 4 + h; float st = 0.f;
#pragma unroll 1
            for (int c0 = 0; c0 < NCH; c0 += 16) { float t[16], d[16];
#pragma unroll
                for (int j = 0; j < 16; ++j) { t[j] = p[(size_t)(c0 + j) * 32768]; d[j] = dec[(c0 + j) * 4]; }
#pragma unroll
                for (int j = 0; j < 16; ++j) { p[(size_t)(c0 + j) * 32768] = st; st = st * d[j] + t[j]; } }
        } else if (idx < 65536 + 32768) { const int i2 = idx - 65536, b = i2 >> 14, rem = i2 & 16383, h = rem >> 12; const float cd = __expf(ret_lg(h) * 128.0f);
            float* p = (float*)((unsigned char*)a.out + DO_RS) + (size_t)b * NCH * 16384 + rem; float st = 0.f;
#pragma unroll 1
            for (int c0 = 0; c0 < NCH; c0 += 16) { float t[16];
#pragma unroll
                for (int j = 0; j < 16; ++j) t[j] = p[(size_t)(c0 + j) * 16384];
#pragma unroll
                for (int j = 0; j < 16; ++j) { p[(size_t)(c0 + j) * 16384] = st; st = st * cd + t[j]; } }
        } else { const int i3 = idx - 65536 - 32768, b = i3 >> 8, ch = i3 & 255;
            const float* ls = (const float*)(a.ws + WS_LSUM) + ((size_t)b * NCH * 256 + ch) * 2; float* lc = (float*)(a.ws + WS_LCARRY) + (size_t)b * NCH * 256 + ch; float hv = 0.f;
#pragma unroll 1
            for (int c0 = 0; c0 < NCH; c0 += 16) { f32x2 t[16];
#pragma unroll
                for (int j = 0; j < 16; ++j) t[j] = *(const f32x2*)(ls + (c0 + j) * 512);
#pragma unroll
                for (int j = 0; j < 16; ++j) { lc[(c0 + j) * 256] = hv; hv = t[j][0] * hv + t[j][1]; } }
        }
    }
}

#define GSYNC() do { XcdBarrier b_; b_.bar = (unsigned*)(kargs()->ws) + CW_BAR; b_.x = xb_xcc_id(); b_.st = MISC; xcd_barrier(b_, wv0); } while (0)
#ifndef REP_MIX1
#define REP_MIX1 1
#endif
#ifndef REP_MIX2
#define REP_MIX2 1
#endif
#ifndef REP_ATTN
#define REP_ATTN 1
#endif
#ifndef REP_GEMM
#define REP_GEMM 1
#endif
#ifndef REP_LN
#define REP_LN 1
#endif
#ifndef REP_SCAN
#define REP_SCAN 1
#endif
#ifndef REP_F1
#define REP_F1 1
#endif
#ifndef REP_OUT
#define REP_OUT 1
#endif
#ifndef REP_SSD
#define REP_SSD 1
#endif
#ifndef REP_RET
#define REP_RET 1
#endif
#ifndef REP_LRU
#define REP_LRU 1
#endif
#ifndef REP_QKV
#define REP_QKV 1
#endif
#define PH_LOCALS const KArgs ka = kargs(); const Args a = *ka; const int tid = ltid(wv0), lane = tid & 63, wave = __builtin_amdgcn_readfirstlane(tid >> 6), bid = lbid(), G = lgdim(), gw = bid * 8 + wave, NGW = G * 8; (void)lane; (void)gw; (void)NGW; unsigned char* const ws = a.ws; (void)ws; \
    bf16_t* const XB = (bf16_t*)(ws + WS_XB); bf16_t* const Hh = (bf16_t*)(ws + WS_H); bf16_t* const Yb = (bf16_t*)(ws + WS_Y); float* const XF = (float*)(ws + WS_XF); unsigned char* const wb = ws + WS_W; \
    (void)XB; (void)Hh; (void)Yb; (void)XF; (void)wb;
__global__ void __launch_bounds__(512, 2) hybrid_fwd(Args unused_args) {
    extern __shared__ __attribute__((aligned(16))) unsigned char lds_raw[];
    LAS unsigned char* lds = (LAS unsigned char*)lds_raw;
    const int wv0 = __builtin_amdgcn_readfirstlane(threadIdx.x >> 6);
    volatile LAS unsigned* MISC = (volatile LAS unsigned*)(lds + LDS_BYTES - 64);
    if (threadIdx.x < 16) MISC[threadIdx.x] = 0u;
    __syncthreads();
    xcd_barrier_post((unsigned*)(kargs()->ws) + CW_BAR, MISC, wv0);
    cg::grid_group grid = cg::this_grid();

#ifndef REP_P0
#define REP_P0 1
#endif
    for (int rep_ = 0; rep_ < REP_P0; ++rep_)
    { PH_LOCALS
#ifndef SK_CONV
      convert_weights(a, 0, lds, wave, lane);
#endif
      const float* x = a.in[0];
#pragma unroll 4
      for (size_t i = (size_t)bid * 512 + tid; i < (size_t)T * DMODEL / 8; i += (size_t)G * 512) { const f32x4 v0 = ((const f32x4*)x)[2 * i], v1 = ((const f32x4*)x)[2 * i + 1];
          u32x4 w; w.x = pk2(v0[0], v0[1]); w.y = pk2(v0[2], v0[3]); w.z = pk2(v1[0], v1[1]); w.w = pk2(v1[2], v1[3]); ((u32x4*)XB)[i] = w; }
      float* r16 = (float*)(ws + WS_ROPE16); float* r64 = (float*)(ws + WS_ROPE64);
      for (int i = bid * 512 + tid; i < T * 40; i += G * 512) { const int row = i / 40, k = i % 40; const float pos = (float)a.pos[row];
          const float inv = k < 8 ? exp2f(-(float)(2 * k) * (13.287712379549449f / 16.0f)) : exp2f(-(float)(2 * (k - 8)) * (13.287712379549449f / 64.0f));
          const float ang = pos * inv; double ad = (double)ang; ad -= 6.283185307179586 * rint(ad * 0.15915494309189535); const float ar = (float)ad; const float sn = __sinf(ar), cs = __cosf(ar);
          if (k < 8) { r16[(size_t)row * 16 + 2 * k] = cs; r16[(size_t)row * 16 + 2 * k + 1] = sn; } else { r64[(size_t)row * 64 + 2 * (k - 8)] = cs; r64[(size_t)row * 64 + 2 * (k - 8) + 1] = sn; } } }
    if (__builtin_expect(kargs()->ws == nullptr, 0)) grid.sync();
    GSYNC();
#ifdef PROBE_CGSYNC
    for (int i_ = 0; i_ < PROBE_CGSYNC; ++i_) grid.sync();
#endif

    for (int l = 0; l < 2; ++l) {
for (int rep_ = 0; rep_ < REP_GEMM; ++rep_) {
#ifndef SK_G_IN
        { PH_LOCALS
          pg8::Gemm g{XB, (const bf16_t*)(wb + W_IN), T, HP, 1024, 1024}; pg8::StaticOrder S; S.init(T, HP, G, bid);
          EpiIn E{Hh, (float*)(ws + WS_DT), (float*)(ws + WS_SSQQ), (float*)(ws + WS_SSQKV)};
          pg8::gemm_phase<EpiIn, pg8::StaticOrder, true, true>(lds, g, S, E, wv0); }
#endif
}

        GSYNC();
for (int rep_ = 0; rep_ < REP_QKV; ++rep_) {
#ifndef SK_G_KV
        { PH_LOCALS
          pg8::Gemm g{Hh + C_CKV, (const bf16_t*)(wb + W_UKV), T, 512, 256, HP}; pg8::StaticOrder S; S.init(T, 512, G, bid);
          EpiKV E{(bf16_t*)((unsigned char*)a.out + DO_K), (bf16_t*)((unsigned char*)a.out + DO_V), Hh, (const float*)(ws + WS_SSQKV), (const float*)(ws + WS_ROPE16)};
          pg8::gemm_phase<EpiKV, pg8::StaticOrder, true, true>(lds, g, S, E, wv0); }
#endif
}

for (int rep_ = 0; rep_ < REP_MIX1; ++rep_) {
#ifndef SK_SSD1
        { PH_LOCALS const LayerP P = layer_params(ka, l);
          for (int r2_ = 0; r2_ < REP_SSD; ++r2_)
          for (int u = bid; u < NB * NCH; u += G) ssd_pass1(lds, a, P, u, wv0); }
#endif
#ifndef SK_RET1
        { PH_LOCALS
          for (int r2_ = 0; r2_ < REP_RET; ++r2_)
          for (int u = bid; u < NB * NCH; u += G) ret_pass1(lds, a, u, wv0); }
#endif
#ifndef SK_LRU0
        { PH_LOCALS const LayerP P = layer_params(ka, l);
          for (int r2_ = 0; r2_ < REP_LRU; ++r2_)
          for (int u = bid; u < NB * NCH; u += G) lru_chunk<0>(lds, a, P, u, wv0); }
#endif
}

        GSYNC();
#ifdef PROBE_SYNCS
        for (int i_ = 0; i_ < PROBE_SYNCS; ++i_) GSYNC();
#endif
#ifndef SK_SCAN
        { PH_LOCALS chunk_scans(a, tid); }
#endif
for (int rep_ = 0; rep_ < REP_QKV; ++rep_) {
#ifndef SK_G_Q
        { PH_LOCALS
          pg8::Gemm g{Hh + C_CQ, (const bf16_t*)(wb + W_UQ), T, 256, 256, HP}; pg8::StaticOrder S; S.init(T, 256, G, (bid + G / 2) % G);
          EpiQ E{(bf16_t*)((unsigned char*)a.out + DO_Q), (const float*)(ws + WS_SSQQ), (const float*)(ws + WS_ROPE16)};
          pg8::gemm_phase<EpiQ, pg8::StaticOrder, true, true>(lds, g, S, E, wv0); }
#endif
}
        GSYNC();
for (int rep_ = 0; rep_ < REP_MIX2; ++rep_) {
#ifndef SK_SSD2
        { PH_LOCALS const LayerP P = layer_params(ka, l);
          for (int r2_ = 0; r2_ < REP_SSD; ++r2_)
          for (int u = bid; u < NB * NCH; u += G) ssd_pass2(lds, a, P, u, wv0); }
#endif
#ifndef SK_RET2
        { PH_LOCALS const LayerP P = layer_params(ka, l);
          for (int r2_ = 0; r2_ < REP_RET; ++r2_)
          for (int u = bid; u < NB * NCH; u += G) ret_pass2(lds, a, P, u, wv0); }
#endif
#ifndef SK_LRU1
        { PH_LOCALS const LayerP P = layer_params(ka, l);
          for (int r2_ = 0; r2_ < REP_LRU; ++r2_)
          for (int u = bid; u < NB * NCH; u += G) lru_out(a, u, wv0); }
#endif
}

        __syncthreads();
for (int rep_ = 0; rep_ < REP_ATTN; ++rep_) {
#ifndef SK_ATTN
        { PH_LOCALS
          const attn_body::AttnTensors AT{(const attn_body::bf16*)((unsigned char*)a.out + DO_Q), (const attn_body::bf16*)((unsigned char*)a.out + DO_K), (const attn_body::bf16*)((unsigned char*)a.out + DO_V), (attn_body::bf16*)Yb};
          const attn_body::StaticOrder S(G, bid);
          attn_body::attn_phase<attn_body::StaticOrder>((char*)lds_raw, AT, S, wv0); }
#endif
}

        GSYNC();
        for (int rep_ = 0; rep_ < REP_OUT; ++rep_) {
        { PH_LOCALS
          pg8::Gemm g{Yb, (const bf16_t*)(wb + W_OUT), T, 1024, 1024, 1024}; pg8::StaticOrder S; S.init(T, 1024, G, bid);
          EpiResA E{l == 0 ? a.in[0] : (const float*)nullptr, XB, XB, (float*)(ws + WS_STAT1)};
          pg8::gemm_phase<EpiResA, pg8::StaticOrder, true, true>(lds, g, S, E, wv0); }
        }
        GSYNC();
        for (int rep_ = 0; rep_ < REP_F1; ++rep_) {
        { PH_LOCALS
          pg8::Gemm g{XB, (const bf16_t*)(wb + W_F1), T, 2 * DFF, 1024, 1024}; pg8::StaticOrder S; S.init(T, 2 * DFF, G, bid);
          EpiSwiGLU E{Hh, (const float*)(ws + WS_STAT1), (const float*)(wb + W_C1F), (const float*)(wb + W_C2F)};
          pg8::gemm_phase<EpiSwiGLU, pg8::StaticOrder, true, true>(lds, g, S, E, wv0); }
        }
        GSYNC();
        { PH_LOCALS const LayerP P = layer_params(ka, l);
          pg8::Gemm g{Hh, (const bf16_t*)(wb + W_F2), T, 1024, DFF, DFF}; pg8::StaticOrder S; S.init(T, 1024, G, bid);
          EpiResB E{XB, XB, l == 0 ? (float*)nullptr : a.out, (const float*)(ws + WS_STAT1), P.ln1g, P.ln1b};
          pg8::gemm_phase<EpiResB, pg8::StaticOrder, true, true>(lds, g, S, E, wv0); }
        GSYNC();
        { PH_LOCALS const LayerP P = layer_params(ka, l);
          if (l == 0) { for (int m = gw; m < T; m += 2 * NGW) { const int m2 = m + NGW < T ? m + NGW : m; ln_rows2_bf16(XB + (size_t)m * DMODEL, XB + (size_t)m2 * DMODEL, P.ln2g, P.ln2b, lane, m2 != m); }
                        __syncthreads();
#ifndef SK_CONV
                        convert_weights(a, 1, lds, wave, lane);
#endif
          }
          else { for (int m = gw; m < T; m += 2 * NGW) { const int m2 = m + NGW < T ? m + NGW : m; ln_rows2_f32(a.out + (size_t)m * DMODEL, a.out + (size_t)m2 * DMODEL, P.ln2g, P.ln2b, lane, m2 != m); } } }
        if (l == 0) GSYNC();
    }
}

extern "C" void kernel_launch(void* const* d_in, const int* in_sizes, int n_in, void* d_out, int out_size, void* d_ws, size_t ws_size, hipStream_t stream) {
    static int grid = 0;
    if (grid == 0) {
        if (n_in != 29 || in_sizes[0] != T * DMODEL || out_size != T * DMODEL || ws_size < WS_END) { fprintf(stderr, "kernel_launch: unexpected shapes (n_in %d, in0 %d, out %d, ws %zu)\n", n_in, n_in > 0 ? in_sizes[0] : -1, out_size, ws_size); grid = -1; return; }
        int dev = 0, cus = 0, per_cu = 0;
        hipGetDevice(&dev); hipDeviceGetAttribute(&cus, hipDeviceAttributeMultiprocessorCount, dev);
        if (hipFuncSetAttribute((const void*)hybrid_fwd, hipFuncAttributeMaxDynamicSharedMemorySize, LDS_BYTES) != hipSuccess) { fprintf(stderr, "kernel_launch: hipFuncSetAttribute failed\n"); grid = -1; return; }
        if (hipOccupancyMaxActiveBlocksPerMultiprocessor(&per_cu, (const void*)hybrid_fwd, 512, LDS_BYTES) != hipSuccess || per_cu < 1) { fprintf(stderr, "kernel_launch: occupancy query gave %d\n", per_cu); per_cu = 1; }
        (void)hipGetLastError();
        grid = cus * 1;
    }
    if (grid < 0) return;
    Args a{};
    for (int i = 0; i < 29; ++i) a.in[i] = (const float*)d_in[i];
    a.pos = (const int*)d_in[1]; a.out = (float*)d_out; a.ws = (unsigned char*)d_ws;
    if (hipMemsetAsync(d_ws, 0, 65536, stream) != hipSuccess) { fprintf(stderr, "kernel_launch: memset failed\n"); return; }
    void* args[] = {&a};
    hipError_t e = hipLaunchCooperativeKernel((const void*)hybrid_fwd, dim3(grid), dim3(512), args, LDS_BYTES, stream);
    if (e != hipSuccess) fprintf(stderr, "cooperative launch failed: %s (grid %d)\n", hipGetErrorString(e), grid);
}
```

```cpp
#include <hip/hip_runtime.h>
#include <hip/hip_cooperative_groups.h>
#include <cstdio>
#include <cstdint>
__device__ __forceinline__ int ltid(int wv) { int l; asm volatile("v_mbcnt_lo_u32_b32 %0, -1, 0\n\tv_mbcnt_hi_u32_b32 %0, -1, %0" : "=v"(l)); asm volatile("" : "+s"(wv)); return (wv << 6) | l; }
__device__ __forceinline__ int lbid() { int b = blockIdx.x; asm volatile("" : "+s"(b)); return b; }
__device__ __forceinline__ int lgdim() { int g = gridDim.x; asm volatile("" : "+s"(g)); return g; }
namespace pg8 {
#define PG8_LAS __attribute__((address_space(3)))
typedef unsigned short bf16_t;
typedef short bf16x8 __attribute__((ext_vector_type(8)));
typedef float f32x4 __attribute__((ext_vector_type(4)));
typedef unsigned u32x4 __attribute__((ext_vector_type(4)));
constexpr int BM = 256, BK = 64, HALF = 128, HTB = HALF * BK * 2  , STAGE_BYTES = 8 * HTB, NXCD = 8, WGM = 8;

__host__ __device__ __forceinline__ int lds_byte(int r, int c) { const int st = (r >> 4) * 2 + (c >> 5), rr = r & 15, cc = c & 31, ob = rr * 64 + cc * 2; return st * 1024 + (ob ^ (((ob >> 9) & 1) << 5)); }
__host__ __device__ __forceinline__ void stage_rc(int b, int& R, int& C) { const int st = b / 1024, sb = b % 1024, swz = sb ^ (((sb >> 9) & 1) << 5); R = (st >> 1) * 16 + swz / 64; C = (st & 1) * 32 + (swz % 64) / 2; }
__host__ __device__ __forceinline__ int perm32(int rho) { const int n = rho >> 4, i = rho & 15; return 8 * (i >> 2) + 4 * n + (i & 3); }

struct Unit { int pm, pn; };
struct Gemm { const bf16_t* A; const bf16_t* Bt; int M, N, K, lda; };

struct StaticOrder {
    int nM, nN, nwg, G, c;
    __host__ __device__ void init(int M, int N, int G_, int c_) { nM = M / BM; nN = N / BM; nwg = nM * nN; G = G_; c = c_; }
    __host__ __device__ bool next(int i, Unit& u) const {
        const long L = (long)i * G + c; if (L >= nwg) return false;
        int wgid = (int)L; { const int q = nwg / NXCD, r = nwg % NXCD, xcd = wgid % NXCD, off = wgid / NXCD; wgid = (xcd < r ? xcd * (q + 1) : r * (q + 1) + (xcd - r) * q) + off; }
        const int nig = WGM * nN, gid = wgid / nig, fm = gid * WGM, gsz = (nM - fm) < WGM ? (nM - fm) : WGM;
        u.pm = fm + ((wgid % nig) % gsz); u.pn = (wgid % nig) / gsz; return true;
    }
    __device__ __forceinline__ void a_ready(const Unit&) const {}
    __device__ __forceinline__ void done(const Unit&) const {}
};

__device__ __forceinline__ unsigned cvt_pk_bf16(float lo, float hi) { unsigned r; asm volatile("v_cvt_pk_bf16_f32 %0, %1, %2" : "=v"(r) : "v"(lo), "v"(hi)); return r; }
typedef float f32x2 __attribute__((ext_vector_type(2)));
template <class Epi, class Sched, bool ALIGN_EPI = false, bool SP2 = false>
__device__ __forceinline__ void gemm_phase(PG8_LAS unsigned char* lds, const Gemm g, const Sched& S, const Epi& E, int wv) {
    const int tid = ltid(wv), wid = __builtin_amdgcn_readfirstlane(tid >> 6), lane = tid & 63, wr = wid >> 2, wc = wid & 3, fr = lane & 15, fq = lane >> 4;
    const int K = g.K, nt = K / BK;
    unsigned voffA[2], voffB[2];
#pragma unroll
    for (int i = 0; i < 2; ++i) { int R, C; stage_rc(tid * 16 + i * 8192, R, C); const int Rb = Epi::PERM ? ((R & ~31) + perm32(R & 31)) : R;
        voffA[i] = (unsigned)(R * g.lda + C) * 2u; voffB[i] = (unsigned)(Rb * K + C) * 2u; }
    const size_t kstep = (size_t)(BK * 2);
    const size_t hstepA = (size_t)HALF * g.lda * 2, hstepB = (size_t)HALF * K * 2;
    const size_t tstepA = 2 * hstepA, tstepB = 2 * hstepB;
    const unsigned ldsw = (unsigned)wid * 1024u;
    const int aoff = lds_byte(wr * 64 + fr, fq * 8), boff = lds_byte(wc * 32 + fr, fq * 8);
#define PG8_SA(b, h) (((b) * 2 + (h)) * HTB)
#define PG8_SB(b, h) ((4 + (b) * 2 + (h)) * HTB)
#define PG8_STAGE(bufoff, gbase, voff) do { _Pragma("unroll") for (int _i = 0; _i < 2; ++_i) \
        __builtin_amdgcn_global_load_lds((const unsigned*)((const char*)(gbase) + (voff)[_i]), (PG8_LAS unsigned*)(lds + (bufoff) + ldsw + _i * 8192), 16, 0, 0); } while (0)
#define PG8_LDA(dst, b, h) do { _Pragma("unroll") for (int m = 0; m < 4; ++m) _Pragma("unroll") for (int k = 0; k < 2; ++k) dst[m][k] = *(const PG8_LAS bf16x8*)(lds + PG8_SA(b, h) + aoff + m * 2048 + k * 1024); } while (0)
#define PG8_LDB(dst, b, h) do { _Pragma("unroll") for (int n = 0; n < 2; ++n) _Pragma("unroll") for (int k = 0; k < 2; ++k) dst[n][k] = *(const PG8_LAS bf16x8*)(lds + PG8_SB(b, h) + boff + n * 2048 + k * 1024); } while (0)
#define PG8_MMA(ai, bj, At, Bt) do { __builtin_amdgcn_s_setprio(1); _Pragma("unroll") for (int m = 0; m < 4; ++m) _Pragma("unroll") for (int n = 0; n < 2; ++n) _Pragma("unroll") for (int k = 0; k < 2; ++k) \
        acc[ai][bj][m][n] = __builtin_amdgcn_mfma_f32_16x16x32_bf16(Bt[n][k], At[m][k], acc[ai][bj][m][n], 0, 0, 0); __builtin_amdgcn_s_setprio(0); } while (0)
#define PG8_WAIT_V(n) asm volatile("s_waitcnt vmcnt(" #n ")" ::: "memory")
#define PG8_WAIT_L(n) asm volatile("s_waitcnt lgkmcnt(" #n ")" ::: "memory")
#define PG8_BAR __builtin_amdgcn_s_barrier()
#define PG8_SCHED __builtin_amdgcn_sched_barrier(0)
    Unit cur, nxt; int ui = 0;
    if (!S.next(0, cur)) return;
    f32x4 acc[2][2][4][2];
#pragma unroll
    for (int a = 0; a < 2; ++a)
#pragma unroll
        for (int b = 0; b < 2; ++b)
#pragma unroll
            for (int m = 0; m < 4; ++m)
#pragma unroll
                for (int n = 0; n < 2; ++n) acc[a][b][m][n] = (f32x4){0.f, 0.f, 0.f, 0.f};
    bf16x8 At[4][2], B0[2][2], B1[2][2];
    const char* cA = (const char*)g.A + (size_t)cur.pm * tstepA; const char* cB = (const char*)g.Bt + (size_t)cur.pn * tstepB;
    S.a_ready(cur);
    if constexpr (SP2) {
        PG8_STAGE(PG8_SB(0, 0), cB, voffB); PG8_STAGE(PG8_SB(0, 1), cB + hstepB, voffB); PG8_STAGE(PG8_SA(0, 0), cA, voffA); PG8_STAGE(PG8_SA(0, 1), cA + hstepA, voffA);
        if (wr == 1) PG8_BAR;
        PG8_WAIT_V(2); PG8_BAR;
        PG8_STAGE(PG8_SB(1, 0), cB + kstep, voffB); PG8_STAGE(PG8_SA(1, 0), cA + kstep, voffA); PG8_STAGE(PG8_SB(1, 1), cB + hstepB + kstep, voffB);
        PG8_WAIT_V(6); PG8_BAR;
    } else {
        PG8_STAGE(PG8_SB(0, 0), cB, voffB); PG8_STAGE(PG8_SA(0, 0), cA, voffA); PG8_STAGE(PG8_SB(0, 1), cB + hstepB, voffB); PG8_STAGE(PG8_SA(0, 1), cA + hstepA, voffA);
        if (wr == 1) PG8_BAR;
        PG8_WAIT_V(4); PG8_BAR;
        PG8_STAGE(PG8_SB(1, 0), cB + kstep, voffB); PG8_STAGE(PG8_SA(1, 0), cA + kstep, voffA); PG8_STAGE(PG8_SB(1, 1), cB + hstepB + kstep, voffB);
        PG8_WAIT_V(6); PG8_BAR;
    }
    for (;;) {
        const bool has_next = S.next(ui + 1, nxt);
        const char* nA = has_next ? (const char*)g.A + (size_t)nxt.pm * tstepA : cA; const char* nB = has_next ? (const char*)g.Bt + (size_t)nxt.pn * tstepB : cB;
#pragma unroll 1
        for (int t = 0; t < nt; t += 2) {
            const bool last = (t == nt - 2);
            const char* a1 = cA + (size_t)(t + 1) * kstep;
            const char* a2 = last ? nA : cA + (size_t)(t + 2) * kstep; const char* b2 = last ? nB : cB + (size_t)(t + 2) * kstep;
            const char* a3 = a2 + kstep; const char* b3 = b2 + kstep;
            if (last && has_next) S.a_ready(nxt);
            if constexpr (SP2) {
            PG8_LDB(B0, 0, 0); PG8_LDB(B1, 0, 1); PG8_SCHED; PG8_LDA(At, 0, 0); PG8_STAGE(PG8_SA(1, 1), a1 + hstepA, voffA);
            PG8_WAIT_V(8); PG8_WAIT_L(0); PG8_BAR; PG8_MMA(0, 0, At, B0); PG8_MMA(0, 1, At, B1); PG8_BAR; PG8_SCHED;
            PG8_LDA(At, 0, 1); PG8_STAGE(PG8_SB(0, 0), b2, voffB); PG8_STAGE(PG8_SB(0, 1), b2 + hstepB, voffB); PG8_STAGE(PG8_SA(0, 0), a2, voffA);
            PG8_WAIT_V(8); PG8_WAIT_L(0); PG8_BAR; PG8_MMA(1, 0, At, B0); PG8_MMA(1, 1, At, B1); PG8_BAR; PG8_SCHED;
            PG8_LDB(B0, 1, 0); PG8_LDB(B1, 1, 1); PG8_SCHED; PG8_LDA(At, 1, 0); PG8_STAGE(PG8_SA(0, 1), a2 + hstepA, voffA);
            PG8_WAIT_V(8); PG8_WAIT_L(0); PG8_BAR; PG8_MMA(0, 0, At, B0); PG8_MMA(0, 1, At, B1); PG8_BAR; PG8_SCHED;
            PG8_LDA(At, 1, 1); PG8_STAGE(PG8_SB(1, 0), b3, voffB); PG8_STAGE(PG8_SB(1, 1), b3 + hstepB, voffB); PG8_STAGE(PG8_SA(1, 0), a3, voffA);
            PG8_WAIT_V(8); PG8_WAIT_L(0); PG8_BAR; PG8_MMA(1, 0, At, B0); PG8_MMA(1, 1, At, B1); PG8_BAR; PG8_SCHED;
            } else {
            PG8_LDB(B0, 0, 0); PG8_SCHED; PG8_LDA(At, 0, 0); PG8_STAGE(PG8_SA(1, 1), a1 + hstepA, voffA);
            PG8_WAIT_L(8); PG8_BAR; PG8_WAIT_L(0); PG8_MMA(0, 0, At, B0); PG8_BAR; PG8_SCHED;
            PG8_LDB(B1, 0, 1); PG8_STAGE(PG8_SB(0, 0), b2, voffB);
            PG8_BAR; PG8_WAIT_L(0); PG8_MMA(0, 1, At, B1); PG8_BAR;
            PG8_LDA(At, 0, 1); PG8_STAGE(PG8_SA(0, 0), a2, voffA);
            PG8_BAR; PG8_WAIT_L(0); PG8_MMA(1, 0, At, B0); PG8_BAR; PG8_SCHED;
            PG8_STAGE(PG8_SB(0, 1), b2 + hstepB, voffB);
            PG8_WAIT_V(6); PG8_BAR; PG8_MMA(1, 1, At, B1); PG8_BAR;
            PG8_LDB(B0, 1, 0); PG8_SCHED; PG8_LDA(At, 1, 0); PG8_STAGE(PG8_SA(0, 1), a2 + hstepA, voffA);
            PG8_WAIT_L(8); PG8_BAR; PG8_WAIT_L(0); PG8_MMA(0, 0, At, B0); PG8_BAR; PG8_SCHED;
            PG8_LDB(B1, 1, 1); PG8_STAGE(PG8_SB(1, 0), b3, voffB);
            PG8_BAR; PG8_WAIT_L(0); PG8_MMA(0, 1, At, B1); PG8_BAR;
            PG8_LDA(At, 1, 1); PG8_STAGE(PG8_SA(1, 0), a3, voffA);
            PG8_BAR; PG8_WAIT_L(0); PG8_MMA(1, 0, At, B0); PG8_BAR; PG8_SCHED;
            PG8_STAGE(PG8_SB(1, 1), b3 + hstepB, voffB);
            PG8_WAIT_V(6); PG8_BAR; PG8_MMA(1, 1, At, B1); PG8_BAR;
            }
        }
        if constexpr (ALIGN_EPI) { if (wr == 0) PG8_BAR; }
        if constexpr (!Epi::AFTER_DRAIN) { E(acc, cur, wr, wc, fr, fq); S.done(cur); }
        if (!has_next) break;
#pragma unroll
        for (int a = 0; a < 2; ++a)
#pragma unroll
            for (int b = 0; b < 2; ++b)
#pragma unroll
                for (int m = 0; m < 4; ++m)
#pragma unroll
                    for (int n = 0; n < 2; ++n) acc[a][b][m][n] = (f32x4){0.f, 0.f, 0.f, 0.f};
        cur = nxt; cA = nA; cB = nB; ++ui;
        if constexpr (ALIGN_EPI) { if (wr == 1) PG8_BAR; }
    }
    PG8_WAIT_V(0);
    if constexpr (!ALIGN_EPI) { if (wr == 0) PG8_BAR; }
    PG8_BAR;
    if constexpr (Epi::AFTER_DRAIN) { E.fused(acc, cur, wr, wc, fr, fq, lds, wid, lane); S.done(cur); }
#undef PG8_SA
#undef PG8_SB
#undef PG8_STAGE
#undef PG8_LDA
#undef PG8_LDB
#undef PG8_MMA
#undef PG8_WAIT_V
#undef PG8_WAIT_L
#undef PG8_BAR
#undef PG8_SCHED
}
}
#include <hip/hip_bf16.h>
#include <cmath>
namespace attn_body {
using bf16=__hip_bfloat16;
using bf16x8=__attribute__((ext_vector_type(8)))short;
using s16x4=__attribute__((ext_vector_type(4)))short;
using f32x16=__attribute__((ext_vector_type(16)))float;
using u32x4=__attribute__((ext_vector_type(4)))unsigned;
constexpr int BATCH=2,NHEAD=4,SEQ=16384,D=64,DM=NHEAD*D,ODM=1024;
constexpr int NW=8,QBLK=32,QB=QBLK*NW,KVBLK=64,NQB=SEQ/QB;
constexpr int ATTN_PITCH=DM, ATTN_UNIT_ROWS=QB;
__device__ __forceinline__ int crow(int r,int hi){return (r&3)+8*(r>>2)+4*hi;}
#define SBAR() __builtin_amdgcn_sched_barrier(0)
__device__ __forceinline__ void cmask(f32x16&p0,f32x16&p1,int jb,int qrel,int hi){
  const float NEG=-INFINITY; int kb=64*jb+4*hi;
  #pragma unroll
  for(int r=0;r<16;++r){int kv=kb+(r&3)+8*(r>>2); if(kv>qrel)p0[r]=NEG; if(kv+32>qrel)p1[r]=NEG;}
}

constexpr int NSLOT=3, SLOTB=8192;
constexpr int LDS_K=0, LDS_V=NSLOT*SLOTB, LDS_WS=2*NSLOT*SLOTB, LDS_OST=LDS_WS+NW*64*4, LDS_BYTES=LDS_OST+NW*4096;
constexpr float C2=0.125f*1.4426950408889634f;
__device__ __forceinline__ void glds16(const void*gsrc,unsigned lds_dst){unsigned keep;
  asm volatile("s_mov_b32 %0, m0\n\ts_mov_b32 m0, %2\n\ts_nop 0\n\tglobal_load_lds_dwordx4 %1, off\n\ts_mov_b32 m0, %0":"=&s"(keep):"v"(gsrc),"s"(lds_dst):"memory");}
__device__ __forceinline__ float max3f(float a,float b,float c){float r;asm("v_max3_f32 %0, %1, %2, %3":"=v"(r):"v"(a),"v"(b),"v"(c));return r;}
__device__ __forceinline__ float max2f(float a,float b){float r;asm("v_max_f32_e32 %0, %1, %2":"=v"(r):"v"(a),"v"(b));return r;}
__device__ __forceinline__ float fadd_s(float a,float b){float r;asm("v_add_f32_e32 %0, %1, %2":"=v"(r):"v"(a),"v"(b));return r;}
__device__ __forceinline__ float fsub_s(float a,float b){float r;asm("v_sub_f32_e32 %0, %1, %2":"=v"(r):"v"(a),"v"(b));return r;}
typedef float f32x2_t __attribute__((ext_vector_type(2))); typedef __bf16 bf16x2_t __attribute__((ext_vector_type(2)));
__device__ __forceinline__ unsigned cvtpk_s(float lo,float hi){f32x2_t v={lo,hi};bf16x2_t b=__builtin_convertvector(v,bf16x2_t);return __builtin_bit_cast(unsigned,b);}
#define WAIT_BAR(N) asm volatile("s_waitcnt vmcnt(" #N ") lgkmcnt(0)\n\ts_barrier":::"memory")

__device__ __forceinline__ void qkt(f32x16&p0,f32x16&p1,const char*Kslot,const bf16x8*qr,const f32x16&negm,int r32,int hi){
  const char*kb=Kslot+hi*1024+r32*16;
  #pragma unroll
  for(int d0=0;d0<3;++d0){
    const bf16x8 b0=*reinterpret_cast<const bf16x8*>(kb+d0*2048);
    const bf16x8 b1=*reinterpret_cast<const bf16x8*>(kb+d0*2048+512);
    if(d0==0){p0=__builtin_amdgcn_mfma_f32_32x32x16_bf16(b0,qr[0],negm,0,0,0);p1=__builtin_amdgcn_mfma_f32_32x32x16_bf16(b1,qr[0],negm,0,0,0);}
    else{p0=__builtin_amdgcn_mfma_f32_32x32x16_bf16(b0,qr[d0],p0,0,0,0);p1=__builtin_amdgcn_mfma_f32_32x32x16_bf16(b1,qr[d0],p1,0,0,0);}}
}
typedef __attribute__((address_space(3))) const char* lds_cptr;
typedef short v4i16_t __attribute__((ext_vector_type(4)));
__device__ __forceinline__ void kload8(bf16x8*kf,lds_cptr kp){
  kf[0]=*(const __attribute__((address_space(3))) bf16x8*)(kp);      kf[1]=*(const __attribute__((address_space(3))) bf16x8*)(kp+512);
  kf[2]=*(const __attribute__((address_space(3))) bf16x8*)(kp+2048); kf[3]=*(const __attribute__((address_space(3))) bf16x8*)(kp+2560);
  kf[4]=*(const __attribute__((address_space(3))) bf16x8*)(kp+4096); kf[5]=*(const __attribute__((address_space(3))) bf16x8*)(kp+4608);
}
__device__ __forceinline__ void kload2(bf16x8*kf,lds_cptr kp,int j){ kf[2*j]=*(const __attribute__((address_space(3))) bf16x8*)(kp+j*2048); kf[2*j+1]=*(const __attribute__((address_space(3))) bf16x8*)(kp+j*2048+512); }
__device__ __forceinline__ s16x4 vtr(lds_cptr p){ return __builtin_bit_cast(s16x4,__builtin_amdgcn_ds_read_tr16_b64_v4i16((__attribute__((address_space(3))) v4i16_t*)p)); }
__device__ __forceinline__ float rowmax(const f32x16&p0,const f32x16&p1){
  float a=max3f(p0[0],p0[1],p1[0]),b=max3f(p0[2],p0[3],p1[1]);a=max3f(a,p1[2],p1[3]);
  #pragma unroll
  for(int r=4;r<16;r+=4){a=max3f(a,p0[r],p0[r+1]);b=max3f(b,p0[r+2],p0[r+3]);a=max3f(a,p1[r],p1[r+1]);b=max3f(b,p1[r+2],p1[r+3]);}
  const float m=max2f(a,b);
  auto rr=__builtin_amdgcn_permlane32_swap(__float_as_uint(m),__float_as_uint(m),false,false);
  return max2f(__uint_as_float(rr[0]),__uint_as_float(rr[1]));
}
__device__ __forceinline__ void pv(f32x16*o,int vb,bf16x8 pa0,bf16x8 pa1,bf16x8 pa2,bf16x8 pa3){
  #pragma unroll
  for(int d0=0;d0<2;++d0){s16x4 lo[4],hi[4];
    #pragma unroll
    for(int ks=0;ks<4;++ks){
      asm volatile("ds_read_b64_tr_b16 %0,%1 offset:%c2":"=&v"(lo[ks]):"v"(vb),"i"(d0*4096+ks*1024):"memory");
      asm volatile("ds_read_b64_tr_b16 %0,%1 offset:%c2":"=&v"(hi[ks]):"v"(vb),"i"(d0*4096+ks*1024+512):"memory");}
    asm volatile("s_waitcnt lgkmcnt(0)":::"memory");SBAR();
    #define PK(k) (bf16x8){lo[k][0],lo[k][1],lo[k][2],lo[k][3],hi[k][0],hi[k][1],hi[k][2],hi[k][3]}
    o[d0]=__builtin_amdgcn_mfma_f32_32x32x16_bf16(pa0,PK(0),o[d0],0,0,0);
    o[d0]=__builtin_amdgcn_mfma_f32_32x32x16_bf16(pa1,PK(1),o[d0],0,0,0);
    o[d0]=__builtin_amdgcn_mfma_f32_32x32x16_bf16(pa2,PK(2),o[d0],0,0,0);
    o[d0]=__builtin_amdgcn_mfma_f32_32x32x16_bf16(pa3,PK(3),o[d0],0,0,0);
    #undef PK
  }
}

#ifndef ATTN_STORE16
#define ATTN_STORE16(p,v) (*(u32x4*)(p)=(v))
#endif
template<int THRL> __device__ __forceinline__ void attn_unit(int b,int h,int qb,const bf16*Q,const bf16*__restrict__ K,const bf16*__restrict__ V,bf16*O,char*shm,int wv){
  const int tid=ltid(wv),lane=tid&63,r32=lane&31,hi=lane>>5; const int wid=__builtin_amdgcn_readfirstlane(tid>>6);
  const long rowbase=(long)b*SEQ; const int q0=qb*QB;
  const bf16*Qw=Q+(rowbase+q0+wid*QBLK)*DM+h*D;
  const bf16*Kh=K+rowbase*DM+h*D,*Vh=V+rowbase*DM+h*D;
  const unsigned lds0=(unsigned)(uintptr_t)shm;
  float*wsf=(float*)(shm+LDS_WS)+wid*64;
  const bf16*ksrc=Kh+(long)lane*DM+wid*8;
  const bf16*vsrc=Vh+(long)(16*(wid&3)+(lane>>2))*DM+(wid>>2)*32+(lane&3)*8;
  const unsigned kdst=lds0+LDS_K+wid*1024, vdst=lds0+LDS_V+wid*1024;
  #define DMA_K(t,slot) glds16(ksrc+(long)(t)*KVBLK*DM,(unsigned)__builtin_amdgcn_readfirstlane(kdst+(slot)))
  #define DMA_V(t,slot) glds16(vsrc+(long)(t)*KVBLK*DM,(unsigned)__builtin_amdgcn_readfirstlane(vdst+(slot)))
  const int vb0=(int)(lds0+LDS_V)+((lane>>4)&1)*32+(lane&3)*8+(4*hi+((lane&15)>>2))*64;
  const char*Kbase=shm+LDS_K; bf16x8 kf[8];
  const lds_cptr shm3=(lds_cptr)shm; const lds_cptr kp0=shm3+LDS_K+hi*1024+r32*16; const lds_cptr vp0=shm3+LDS_V+((lane>>4)&1)*32+(lane&3)*8+(4*hi+((lane&15)>>2))*64;
  const int NT=(q0+QB)/KVBLK;
  DMA_K(0,0);DMA_V(0,0);DMA_K(1,SLOTB);
  bf16x8 qr[4];
  #pragma unroll
  for(int d0=0;d0<3;++d0)qr[d0]=*reinterpret_cast<const bf16x8*>(&Qw[(long)r32*DM+d0*16+hi*8]);
  float mhat=0.f,l_reg=0.f;f32x16 o[2];o[0]=f32x16{};o[1]=f32x16{};f32x16 negm=f32x16{};asm volatile("":"+v"(negm));
  const int qrel=wid*QBLK+r32;
  #define CMASK(P0,P1,t) do{int jb_=(t)-(NT-4); if(jb_>=0)cmask(P0,P1,jb_,qrel,hi);}while(0)
  bool resc=false;
  #define START(P0,P1) do{ const float rm=rowmax(P0,P1); resc=false; \
    { const float dl=rm; mhat=fadd_s(mhat,dl); \
      _Pragma("unroll") for(int r=0;r<16;++r){P0[r]=fsub_s(P0[r],dl);P1[r]=fsub_s(P1[r],dl);} \
      _Pragma("unroll") for(int r=0;r<16;++r)negm[r]=-mhat; asm volatile("":"+v"(negm)); } \
    _Pragma("unroll") for(int r=0;r<16;++r)P0[r]=__builtin_amdgcn_exp2f(P0[r]); }while(0)
  #define RESC() do{ if(resc){ asm volatile("s_waitcnt lgkmcnt(0)":::"memory"); \
      _Pragma("unroll") for(int d_=0;d_<2;++d_) _Pragma("unroll") for(int r=0;r<16;++r)o[d_][r]*=wsf[crow(r,hi)]; } }while(0)
  f32x16 pA0,pA1,pB0,pB1;
  int sl_prev=0,sl_cur=0,sl_next=SLOTB;
  #define ROT() do{sl_prev=sl_cur;sl_cur=sl_next;sl_next=(sl_next==(NSLOT-1)*SLOTB)?0:sl_next+SLOTB;}while(0)
  DMA_K(2,2*SLOTB);
  WAIT_BAR(3);
  qkt(pA0,pA1,Kbase,qr,negm,r32,hi);asm volatile("s_nop 15\n\ts_nop 7":"+v"(pA0),"+v"(pA1));CMASK(pA0,pA1,0);
  START(pA0,pA1);
  _Pragma("unroll") for(int r=0;r<16;++r)pA1[r]=__builtin_amdgcn_exp2f(pA1[r]);
  WAIT_BAR(0);
  DMA_K(3,0);DMA_V(1,SLOTB);
  ROT();
  kload8(kf,kp0+sl_cur);
  WAIT_BAR(2);
  s16x4 vlo[8],vhi[8]; u32x4 pw0,pw1,pw2,pw3;
  #define PKW(P,B) cvtpk_s(P[B],P[B+1])
  #define PAF(k) __builtin_bit_cast(bf16x8,pw##k)
  #define VFR(i) (bf16x8){vlo[i][0],vlo[i][1],vlo[i][2],vlo[i][3],vhi[i][0],vhi[i][1],vhi[i][2],vhi[i][3]}
  #define PIN(x) asm volatile("":"+v"(x))
  #define MX3(a,b,c) __builtin_fmaxf(__builtin_fmaxf((a),(b)),(c))
  #define GAPA(MF,A0,A1,A2,A3,W0,W1,PW) do{ MF; sacc+=(f32x2_t){A0,A1}; sacc+=(f32x2_t){A2,A3}; PIN(sacc); W0; W1; PIN(PW); SBAR(); }while(0)
  #define EX(v) __builtin_amdgcn_exp2f(v)
  #define GAPB(MF,X,B) do{ MF; X[B]=EX(X[B]); X[B+1]=EX(X[B+1]); X[B+2]=EX(X[B+2]); X[B+3]=EX(X[B+3]); PIN(X); SBAR(); }while(0)
  #define VRD(i) do{ vlo[i]=vtr(vp_+(((i)>>2)*4096+((i)&3)*1024)); vhi[i]=vtr(vp_+(((i)>>2)*4096+((i)&3)*1024+512)); }while(0)
  #define KRD(G,j) do{ if(G){ kload2(kf,kp0+sl_next,j); SBAR(); } }while(0)
  #define STEP(C0,C1,P0,P1,t,GK,GV,GL) do{ SBAR(); \
    const lds_cptr vp_=vp0+sl_prev; \
    VRD(0); SBAR(); f32x2_t sacc=(f32x2_t){P0[0],P0[1]}; \
    GAPA(C0=__builtin_amdgcn_mfma_f32_32x32x16_bf16(kf[0],qr[0],negm,0,0,0), P0[2],P0[3],P0[4],P0[5],     pw0[0]=PKW(P0,0), pw0[1]=PKW(P0,2), pw0); \
    VRD(4); SBAR(); GAPA(C1=__builtin_amdgcn_mfma_f32_32x32x16_bf16(kf[1],qr[0],negm,0,0,0), P0[6],P0[7],P0[8],P0[9],     pw0[2]=PKW(P0,4), pw0[3]=PKW(P0,6), pw0); \
    VRD(1); SBAR(); GAPA(C0=__builtin_amdgcn_mfma_f32_32x32x16_bf16(kf[2],qr[1],C0,0,0,0),   P0[10],P0[11],P0[12],P0[13], pw1[0]=PKW(P0,8), pw1[1]=PKW(P0,10), pw1); \
    VRD(5); SBAR(); GAPA(C1=__builtin_amdgcn_mfma_f32_32x32x16_bf16(kf[3],qr[1],C1,0,0,0),   P0[14],P0[15],P1[0],P1[1],   pw1[2]=PKW(P0,12),pw1[3]=PKW(P0,14), pw1); \
    VRD(2); SBAR(); GAPA(C0=__builtin_amdgcn_mfma_f32_32x32x16_bf16(kf[4],qr[2],C0,0,0,0),   P1[2],P1[3],P1[4],P1[5],     pw2[0]=PKW(P1,0), pw2[1]=PKW(P1,2), pw2); \
    VRD(6); SBAR(); GAPA(C1=__builtin_amdgcn_mfma_f32_32x32x16_bf16(kf[5],qr[2],C1,0,0,0),   P1[6],P1[7],P1[8],P1[9],     pw2[2]=PKW(P1,4), pw2[3]=PKW(P1,6), pw2); \
    VRD(3); SBAR(); GAPA((void)0,   P1[10],P1[11],P1[12],P1[13], pw3[0]=PKW(P1,8), pw3[1]=PKW(P1,10), pw3); \
    VRD(7); SBAR(); GAPA((void)0,   P1[14],P1[15],0.f,0.f,       pw3[2]=PKW(P1,12),pw3[3]=PKW(P1,14), pw3); \
    l_reg+=(sacc.x+sacc.y); \
    if(GK){DMA_K((t)+3,sl_cur);} if(GV){DMA_V((t)+1,sl_next);} \
    CMASK(C0,C1,t); \
    { float a=MX3(C0[0],C0[1],C1[0]),b=MX3(C0[2],C0[3],C1[1]); a=MX3(a,C1[2],C1[3]); \
      _Pragma("unroll") for(int r=4;r<16;r+=4){a=MX3(a,C0[r],C0[r+1]);b=MX3(b,C0[r+2],C0[r+3]);a=MX3(a,C1[r],C1[r+1]);b=MX3(b,C1[r+2],C1[r+3]);} \
      float rm=__builtin_fmaxf(a,b); { auto rr=__builtin_amdgcn_permlane32_swap(__float_as_uint(rm),__float_as_uint(rm),false,false); rm=__builtin_fmaxf(__uint_as_float(rr[0]),__uint_as_float(rr[1])); } \
      resc=false; \
      if(__builtin_expect(__any(rm>(float)THRL),0)){ const float dl=__builtin_fmaxf(rm,0.f); mhat+=dl; \
        _Pragma("unroll") for(int r=0;r<16;++r){C0[r]-=dl;C1[r]-=dl;} \
        _Pragma("unroll") for(int r=0;r<16;++r)negm[r]=-mhat; asm volatile("":"+v"(negm)); \
        const float f=__builtin_amdgcn_exp2f(-dl); l_reg*=f; if(hi==0)wsf[r32]=f; resc=true; } } \
    SBAR(); \
    GAPB(o[0]=__builtin_amdgcn_mfma_f32_32x32x16_bf16(PAF(0),VFR(0),o[0],0,0,0), C0,0); \
    GAPB(o[1]=__builtin_amdgcn_mfma_f32_32x32x16_bf16(PAF(0),VFR(4),o[1],0,0,0), C0,4); \
    KRD(GL,0); GAPB(o[0]=__builtin_amdgcn_mfma_f32_32x32x16_bf16(PAF(1),VFR(1),o[0],0,0,0), C0,8); \
    KRD(GL,1); GAPB(o[1]=__builtin_amdgcn_mfma_f32_32x32x16_bf16(PAF(1),VFR(5),o[1],0,0,0), C0,12); \
    KRD(GL,2); GAPB(o[0]=__builtin_amdgcn_mfma_f32_32x32x16_bf16(PAF(2),VFR(2),o[0],0,0,0), C1,0); \
    GAPB(o[1]=__builtin_amdgcn_mfma_f32_32x32x16_bf16(PAF(2),VFR(6),o[1],0,0,0), C1,4); \
    GAPB(o[0]=__builtin_amdgcn_mfma_f32_32x32x16_bf16(PAF(3),VFR(3),o[0],0,0,0), C1,8); \
    GAPB(o[1]=__builtin_amdgcn_mfma_f32_32x32x16_bf16(PAF(3),VFR(7),o[1],0,0,0), C1,12); \
    }while(0)
  int t=1;
  #undef CMASK
  #define CMASK(P0,P1,t) do{}while(0)
  for(;t+5<NT;t+=2){
    STEP(pB0,pB1,pA0,pA1,t,true,true,true);     WAIT_BAR(2); RESC(); ROT();
    STEP(pA0,pA1,pB0,pB1,t+1,true,true,true);   WAIT_BAR(2); RESC(); ROT();
  }
  #undef CMASK
  #define CMASK(P0,P1,t) do{int jb_=(t)-(NT-4); if(jb_>=0)cmask(P0,P1,jb_,qrel,hi);}while(0)
  #define ENDW(tt) do{ if((tt)+3<NT){WAIT_BAR(2);} else if((tt)+2<NT){WAIT_BAR(1);} else {WAIT_BAR(0);} }while(0)
  for(;t+1<NT;t+=2){
    STEP(pB0,pB1,pA0,pA1,t,(t+3<NT),(t+1<NT),(t+1<NT));       ENDW(t);   RESC(); ROT();
    STEP(pA0,pA1,pB0,pB1,t+1,(t+4<NT),(t+2<NT),(t+2<NT));     ENDW(t+1); RESC(); ROT();
  }
  STEP(pB0,pB1,pA0,pA1,NT-1,false,false,false); RESC();
  { float sacc=pB0[0]+pB0[1]; _Pragma("unroll") for(int r=2;r<16;++r)sacc+=pB0[r]; _Pragma("unroll") for(int r=0;r<16;++r)sacc+=pB1[r]; l_reg+=sacc;
    pw0=(u32x4){PKW(pB0,0),PKW(pB0,2),PKW(pB0,4),PKW(pB0,6)};pw1=(u32x4){PKW(pB0,8),PKW(pB0,10),PKW(pB0,12),PKW(pB0,14)};pw2=(u32x4){PKW(pB1,0),PKW(pB1,2),PKW(pB1,4),PKW(pB1,6)};pw3=(u32x4){PKW(pB1,8),PKW(pB1,10),PKW(pB1,12),PKW(pB1,14)};
    SBAR(); pv(o,vb0+sl_cur,PAF(0),PAF(1),PAF(2),PAF(3)); }
  #undef PKW
  #undef PAF
  #undef VFR
  #undef PIN
  #undef MX3
  #undef GAPA
  #undef GAPB
  #undef EX
  #undef VRD
  #undef KRD
  #undef STEP
  #undef ENDW
  {auto rr=__builtin_amdgcn_permlane32_swap(__float_as_uint(l_reg),__float_as_uint(l_reg),false,false);l_reg=__uint_as_float(rr[0])+__uint_as_float(rr[1]);}
  if(hi==0)wsf[32+r32]=l_reg;asm volatile("s_waitcnt lgkmcnt(0)":::"memory");
  float rli[16];
  #pragma unroll
  for(int r=0;r<16;++r)rli[r]=__builtin_amdgcn_rcpf(wsf[32+crow(r,hi)]);
  bf16*Ow=O+(rowbase+q0+wid*QBLK)*ODM+h*D;
  { bf16*stg=(bf16*)(shm+LDS_OST)+wid*2048;
    #pragma unroll
    for(int r=0;r<16;++r){const int orow=crow(r,hi);
      #pragma unroll
      for(int d0=0;d0<2;++d0)stg[orow*64+d0*32+r32]=__float2bfloat16(o[d0][r]*rli[r]);}
    asm volatile("s_waitcnt lgkmcnt(0)":::"memory");
    #pragma unroll
    for(int i=0;i<4;++i){const int row=i*8+(lane>>3),ch=lane&7; const u32x4 v=*(const u32x4*)(stg+row*64+ch*8); ATTN_STORE16(Ow+(long)row*ODM+ch*8,v);} }
  asm volatile("s_waitcnt lgkmcnt(0)\n\ts_barrier":::"memory");
  #undef DMA_K
  #undef DMA_V
  #undef CMASK
  #undef START
  #undef RESC
  #undef ROT
}
constexpr int ATTN_LDS_BYTES=LDS_BYTES;
struct AttnTensors { const bf16* Q; const bf16* K; const bf16* V; bf16* O; };
struct AttnUnit { int bh; int qb; };
struct StaticOrder {
  int vcu, G;
  __device__ __forceinline__ explicit StaticOrder(int grid,int block):vcu((grid%8==0)?(block%8)*(grid/8)+block/8:block),G(grid){}
  __device__ __forceinline__ bool next(int i,AttnUnit&u)const{ const int pair=vcu+(i>>1)*G; if(pair>=BATCH*NHEAD*(NQB/2))return false; const int s=pair%(NQB/2); u.bh=pair/(NQB/2); u.qb=(i&1)?(NQB-1-s):s; return true; }
  __device__ __forceinline__ void a_ready(const AttnUnit&)const{}
  __device__ __forceinline__ void done(const AttnUnit&)const{}
};
template<class Sched,int THRL=8> __device__ __forceinline__ void attn_phase(char*lds,const AttnTensors&T,const Sched&S,int wv){
  AttnUnit u;
  for(int i=0;S.next(i,u);++i){ S.a_ready(u); attn_unit<THRL>(u.bh/NHEAD,u.bh%NHEAD,u.qb,T.Q,T.K,T.V,T.O,lds,wv); S.done(u); }
}
#undef SBAR
#undef WAIT_BAR
}
namespace cg = cooperative_groups;
#define DI __device__ __forceinline__
#define LAS __attribute__((address_space(3)))
typedef unsigned short bf16_t;
typedef short bf16x8 __attribute__((ext_vector_type(8)));
typedef float f32x4 __attribute__((ext_vector_type(4)));
typedef float f32x2 __attribute__((ext_vector_type(2)));
typedef unsigned u32x4 __attribute__((ext_vector_type(4)));
typedef unsigned u32x2 __attribute__((ext_vector_type(2)));

#define XB_TMO      128
#define XB_XCNT(j)  (256  + 64 * (j))
#define XB_XSUB(j)  (1280 + 64 * (j))
#define XB_XGEN(j)  (2304 + 64 * (j))
#define XB_TOP      3328
#define XB_TOPGEN   3392
#define XCD_BAR_WORDS 3456
#define XB_SPIN_CAP (1u << 18)

__device__ __forceinline__ unsigned xb_ld(unsigned* p)              { return __hip_atomic_load(p, __ATOMIC_RELAXED, __HIP_MEMORY_SCOPE_AGENT); }
__device__ __forceinline__ unsigned xb_add(unsigned* p, unsigned v) { return __hip_atomic_fetch_add(p, v, __ATOMIC_RELAXED, __HIP_MEMORY_SCOPE_AGENT); }
__device__ __forceinline__ unsigned xb_xcc_id() { return (unsigned)__builtin_amdgcn_s_getreg((3 << 11) | 20) & 0xFu; }
#define XB_SPIN(cond, bar) do { unsigned _sp = 0; while (cond) { __builtin_amdgcn_s_sleep(1); \
    if ((++_sp & 255u) == 0u) { if (xb_ld(&(bar)[XB_TMO])) break; if (_sp > XB_SPIN_CAP) { atomicAdd(&(bar)[XB_TMO], 1u); break; } } } } while (0)

struct XcdBarrier {
    unsigned* bar; unsigned x;
    volatile LAS unsigned* st;
};

__device__ __forceinline__ XcdBarrier xcd_barrier_post(unsigned* bar, volatile LAS unsigned* st, int wv) {
    XcdBarrier b; b.bar = bar; b.x = xb_xcc_id(); b.st = st;
    if (ltid(wv) == 0) (void)xb_add(&bar[XB_XCNT(b.x)], 1u);
    return b;
}
__device__ __forceinline__ void xcd_barrier_complete(unsigned* bar, unsigned x, unsigned& nloc, unsigned& nx) {
    const unsigned G = gridDim.x * gridDim.y * gridDim.z;
    unsigned sum, cnt, mine, sp = 0u;
    for (;;) {
        sum = 0u; cnt = 0u; mine = 0u;
#pragma unroll
        for (unsigned j = 0; j < 16; ++j) { const unsigned c = xb_ld(&bar[XB_XCNT(j)]); sum += c; cnt += (c > 0u) ? 1u : 0u; mine = (j == x) ? c : mine; }
        if (sum == G) break;
        __builtin_amdgcn_s_sleep(1);
        if ((++sp & 255u) == 0u) { if (xb_ld(&bar[XB_TMO])) break; if (sp > XB_SPIN_CAP) { atomicAdd(&bar[XB_TMO], 1u); break; } }
    }
    nloc = mine > 0u ? mine : 1u; nx = cnt > 0u ? cnt : 1u;
}

__device__ __forceinline__ void xcd_barrier(const XcdBarrier& b, int wv) {
    asm volatile("s_waitcnt vmcnt(0)" ::: "memory");
    __syncthreads();
    if (ltid(wv) == 0) {
        unsigned* bar = b.bar;
        __builtin_amdgcn_s_waitcnt(0);
        unsigned nloc = b.st[0], nx = b.st[1];
        if (nloc == 0u) { xcd_barrier_complete(bar, b.x, nloc, nx); b.st[0] = nloc; b.st[1] = nx; }
        const unsigned old = xb_add(&bar[XB_XSUB(b.x)], 1u);
        const unsigned gen = old / nloc;
        if (old + 1u == (gen + 1u) * nloc) {
            __builtin_amdgcn_fence(__ATOMIC_RELEASE, "agent");
            asm volatile("s_waitcnt vmcnt(0)" ::: "memory");
            const unsigned og = xb_add(&bar[XB_TOP], 1u);
            const unsigned tg = og / nx;
            if (og + 1u == (tg + 1u) * nx) xb_add(&bar[XB_TOPGEN], 1u);
            else XB_SPIN(xb_ld(&bar[XB_TOPGEN]) == tg, bar);
            __builtin_amdgcn_fence(__ATOMIC_ACQUIRE, "agent");
            xb_add(&bar[XB_XGEN(b.x)], 1u);
            asm volatile("s_waitcnt vmcnt(0)" ::: "memory");
        } else {
            XB_SPIN(xb_ld(&bar[XB_XGEN(b.x)]) == gen, bar);
            __builtin_amdgcn_fence(__ATOMIC_ACQUIRE, "agent");
            asm volatile("s_waitcnt vmcnt(0)" ::: "memory");
        }
    }
    __syncthreads();
}

constexpr int SEQ = 16384, NB = 2, T = NB * SEQ, DMODEL = 1024, NIN = 2964, HP = 3072, DFF = 2816, NCH = SEQ / 128;
constexpr float EPS = 1e-5f, ALPHA = 1.4142135623730951f;
constexpr int C_CQ = 0, C_CKV = 256, C_KR = 384, C_Z = 400, C_XBC = 656, C_RQ = 1424, C_RK = 1680, C_RV = 1936, C_RG = 2192, C_LX = 2448, C_LG = 2704, C_DT = 2960;
constexpr float QSCALE = 0.14433756729740643f * 1.4426950408889634f;

constexpr size_t MiB = 1u << 20;
constexpr size_t WS_W = 1 * MiB;
constexpr size_t W_IN = 0, W_OUT = 6 * MiB, W_F1 = 8 * MiB, W_F2 = 19 * MiB, W_UQ = 24 * MiB + 512 * 1024, W_UKV = W_UQ + 128 * 1024, W_LRU = W_UKV + 256 * 1024;
constexpr size_t WS_ROPE16 = 27 * MiB, WS_ROPE64 = 29 * MiB;
constexpr size_t WS_DT = 37 * MiB, WS_SSQQ = WS_DT + 512 * 1024, WS_SSQKV = WS_SSQQ + 512 * 1024, WS_SDEC = WS_SSQKV + 512 * 1024, WS_LSUM = WS_SDEC + 64 * 1024, WS_LCARRY = WS_LSUM + 512 * 1024;
constexpr size_t WS_XB = 40 * MiB, WS_H = 104 * MiB, WS_Y = 296 * MiB, WS_XF = 360 * MiB, WS_STAT1 = 488 * MiB, WS_END = 492 * MiB;
constexpr size_t WS_YT = WS_XF, WS_LSW = WS_XF + 32 * MiB;
constexpr size_t WS_LA = WS_XF + 40 * MiB, WS_LI = WS_XF + 72 * MiB;
constexpr size_t W_PART1 = 25 * MiB, W_PART2 = W_PART1 + 384 * 1024, W_C1F = W_PART2 + 384 * 1024, W_C2F = W_C1F + 32 * 1024;
constexpr size_t DO_Q = 0, DO_K = 16 * MiB, DO_V = 32 * MiB, DO_ST = 48 * MiB, DO_RS = 80 * MiB;

constexpr int LDS_BYTES = 147456;
constexpr int CW_BAR = 1024;

struct Args {
    const float* in[29];
    const int* pos;
    float* out;
    unsigned char* ws;
};

#if defined(__HIP_DEVICE_COMPILE__)
typedef const __attribute__((address_space(4))) Args* KArgs;
DI KArgs kargs() { KArgs p = (KArgs)__builtin_amdgcn_kernarg_segment_ptr(); asm volatile("" : "+s"(p)); return p; }
#else
typedef const Args* KArgs;
DI KArgs kargs() { return nullptr; }
#endif
DI float bperm(float v, int srclane) { return __int_as_float(__builtin_amdgcn_ds_bpermute(srclane << 2, __float_as_int(v))); }
DI float bf2f(unsigned short u) { return __uint_as_float((unsigned)u << 16); }
typedef __bf16 hwbf16x2 __attribute__((ext_vector_type(2)));
DI unsigned pk2(float lo, float hi) { const f32x2 v = {lo, hi}; const hwbf16x2 b = __builtin_convertvector(v, hwbf16x2); return __builtin_bit_cast(unsigned, b); }
DI unsigned short f2bf(float f) { return (unsigned short)(pk2(f, 0.f) & 0xffffu); }
DI float silu_f(float x) { return x * __builtin_amdgcn_rcpf(1.0f + __expf(-x)); }
DI float sigmoid_f(float x) { return __builtin_amdgcn_rcpf(1.0f + __expf(-x)); }
DI float softplus_f(float x) { return x > 20.f ? x : log1pf(__expf(x)); }
DI float gelu_tanh_f(float x) { const float u = 0.7978845608028654f * (x + 0.044715f * x * x * x); const float th = 1.0f - 2.0f * __builtin_amdgcn_rcpf(1.0f + __expf(2.0f * u)); return 0.5f * x * (1.0f + th); }
DI float one_minus_exp(float x) { const float p = -x * (1.0f + x * (0.5f + x * (0.16666667f + x * (0.041666668f + x * 0.008333334f)))); if (__builtin_expect(__any(x <= -0.5f), 0)) return x > -0.5f ? p : 1.0f - __expf(x); return p; }
DI void unpack8(const u32x4 v, float (&o)[8]) {
    o[0] = __uint_as_float(v.x << 16); o[1] = __uint_as_float(v.x & 0xffff0000u); o[2] = __uint_as_float(v.y << 16); o[3] = __uint_as_float(v.y & 0xffff0000u);
    o[4] = __uint_as_float(v.z << 16); o[5] = __uint_as_float(v.z & 0xffff0000u); o[6] = __uint_as_float(v.w << 16); o[7] = __uint_as_float(v.w & 0xffff0000u);
}
DI u32x4 pack8(const float (&v)[8]) { u32x4 w; w.x = pk2(v[0], v[1]); w.y = pk2(v[2], v[3]); w.z = pk2(v[4], v[5]); w.w = pk2(v[6], v[7]); return w; }

struct EpiIn {
    static constexpr bool PERM = true, AFTER_DRAIN = false;
    bf16_t* H; float* DT; float* SSQQ; float* SSQKV;
    DI void operator()(const f32x4 (&acc)[2][2][4][2], const pg8::Unit& u, int wr, int wc, int fr, int fq) const {
        asm volatile("" : "+v"(fr), "+v"(fq));
        const int row0 = u.pm * 256 + wr * 64 + fr, col0 = u.pn * 256 + wc * 32 + 8 * fq, lane = fq * 16 + fr;
#pragma unroll
        for (int ai = 0; ai < 2; ++ai)
#pragma unroll
            for (int m = 0; m < 4; ++m) {
                const int row = row0 + ai * 128 + m * 16; bf16_t* rowp = H + (size_t)row * HP + col0; float ss[2];
#pragma unroll
                for (int bj = 0; bj < 2; ++bj) { const f32x4 v0 = acc[ai][bj][m][0], v1 = acc[ai][bj][m][1];
                    u32x4 w; w.x = pk2(v0[0], v0[1]); w.y = pk2(v0[2], v0[3]); w.z = pk2(v1[0], v1[1]); w.w = pk2(v1[2], v1[3]);
                    *(u32x4*)(rowp + bj * 128) = w;
                    ss[bj] = (v0[0] * v0[0] + v0[1] * v0[1]) + (v0[2] * v0[2] + v0[3] * v0[3]) + (v1[0] * v1[0] + v1[1] * v1[1]) + (v1[2] * v1[2] + v1[3] * v1[3]); }
                if (u.pn == 0) { float s = ss[0] + ss[1]; s += bperm(s, lane ^ 16); s += bperm(s, lane ^ 32); if (fq == 0) SSQQ[(size_t)row * 4 + wc] = s; }
                else if (u.pn == 1) { float s = ss[0]; s += bperm(s, lane ^ 16); s += bperm(s, lane ^ 32); if (fq == 0) SSQKV[(size_t)row * 4 + wc] = s; }
                else if (u.pn == 11) { if (wc == 0 && fq == 2) *(f32x4*)(DT + (size_t)row * 4) = acc[ai][1][m][0]; }
            }
    }
};
DI void rope4(f32x4& v0, f32x4& v1, const float* tab_row, int fq) {
    const f32x4 cs0 = *(const f32x4*)(tab_row + 8 * fq), cs1 = *(const f32x4*)(tab_row + 8 * fq + 4);
    const float c[4] = {cs0[0], cs0[2], cs1[0], cs1[2]}, s[4] = {cs0[1], cs0[3], cs1[1], cs1[3]};
    f32x4 a, b;
#pragma unroll
    for (int j = 0; j < 4; ++j) { a[j] = v0[j] * c[j] - v1[j] * s[j]; b[j] = v0[j] * s[j] + v1[j] * c[j]; }
    v0 = a; v1 = b;
}
struct EpiQ {
    static constexpr bool PERM = true, AFTER_DRAIN = false;
    bf16_t* Q; const float* SSQ; const float* ROPE16;
    DI void operator()(const f32x4 (&acc)[2][2][4][2], const pg8::Unit& u, int wr, int wc, int fr, int fq) const {
        asm volatile("" : "+v"(fr), "+v"(fq));
        const int row0 = u.pm * 256 + wr * 64 + fr, col0 = wc * 32 + 8 * fq;
#pragma unroll
        for (int ai = 0; ai < 2; ++ai)
#pragma unroll
            for (int m = 0; m < 4; ++m) {
                const int row = row0 + ai * 128 + m * 16; const f32x4 p = *(const f32x4*)(SSQ + (size_t)row * 4);
                const float rs = QSCALE * __builtin_amdgcn_rsqf(((p[0] + p[1]) + (p[2] + p[3])) * (1.0f / 256.0f) + EPS);
#pragma unroll
                for (int bj = 0; bj < 2; ++bj) { f32x4 v0 = acc[ai][bj][m][0] * rs, v1 = acc[ai][bj][m][1] * rs;
                    if ((wc & 1) && fq < 2) rope4(v0, v1, ROPE16 + (size_t)row * 16, fq);
                    u32x4 w; w.x = pk2(v0[0], v0[1]); w.y = pk2(v0[2], v0[3]); w.z = pk2(v1[0], v1[1]); w.w = pk2(v1[2], v1[3]);
                    *(u32x4*)(Q + (size_t)row * 256 + bj * 128 + col0) = w; }
                asm volatile("" ::: "memory");
            }
    }
};
struct EpiKV {
    static constexpr bool PERM = true, AFTER_DRAIN = false;
    bf16_t* Kb; bf16_t* Vb; const bf16_t* H; const float* SSQ; const float* ROPE16;
    DI void operator()(const f32x4 (&acc)[2][2][4][2], const pg8::Unit& u, int wr, int wc, int fr, int fq) const {
        asm volatile("" : "+v"(fr), "+v"(fq));
        const int row0 = u.pm * 256 + wr * 64 + fr, col0 = wc * 32 + 8 * fq;
        bf16_t* dst = u.pn == 0 ? Kb : Vb;
#pragma unroll
        for (int ai = 0; ai < 2; ++ai)
#pragma unroll
            for (int m = 0; m < 4; ++m) {
                const int row = row0 + ai * 128 + m * 16; const f32x4 p = *(const f32x4*)(SSQ + (size_t)row * 4);
                const float rs = __builtin_amdgcn_rsqf(((p[0] + p[1]) + (p[2] + p[3])) * (1.0f / 128.0f) + EPS);
#pragma unroll
                for (int bj = 0; bj < 2; ++bj) { f32x4 v0 = acc[ai][bj][m][0] * rs, v1 = acc[ai][bj][m][1] * rs;
                    if (u.pn == 0 && (wc & 1)) {
                        if (fq < 2) { const u32x2 a = *(const u32x2*)(H + (size_t)row * HP + C_KR + 4 * fq), b = *(const u32x2*)(H + (size_t)row * HP + C_KR + 8 + 4 * fq);
                            v0 = (f32x4){__uint_as_float(a.x << 16), __uint_as_float(a.x & 0xffff0000u), __uint_as_float(a.y << 16), __uint_as_float(a.y & 0xffff0000u)};
                            v1 = (f32x4){__uint_as_float(b.x << 16), __uint_as_float(b.x & 0xffff0000u), __uint_as_float(b.y << 16), __uint_as_float(b.y & 0xffff0000u)};
                            rope4(v0, v1, ROPE16 + (size_t)row * 16, fq); }
                        else { v0 = (f32x4){0.f, 0.f, 0.f, 0.f}; v1 = v0; }
                    }
                    u32x4 w; w.x = pk2(v0[0], v0[1]); w.y = pk2(v0[2], v0[3]); w.z = pk2(v1[0], v1[1]); w.w = pk2(v1[2], v1[3]);
                    *(u32x4*)(dst + (size_t)row * 256 + bj * 128 + col0) = w; }
                asm volatile("" ::: "memory");
            }
    }
};
DI void row_stats(const float* STAT, int row, int fq, int lane, float& mu, float& rstd) {
    const f32x4 a = *(const f32x4*)(STAT + (size_t)row * 32 + fq * 8), b = *(const f32x4*)(STAT + (size_t)row * 32 + fq * 8 + 4);
    float s = (a[0] + a[2]) + (b[0] + b[2]), q = (a[1] + a[3]) + (b[1] + b[3]);
    s += bperm(s, lane ^ 16); q += bperm(q, lane ^ 16); s += bperm(s, lane ^ 32); q += bperm(q, lane ^ 32);
    mu = s * (1.0f / 1024.0f); rstd = __builtin_amdgcn_rsqf(fmaxf(q * (1.0f / 1024.0f) - mu * mu, 0.f) + EPS);
}
DI f32x4 bf4_to_f32(const u32x2 v) { return (f32x4){__uint_as_float(v.x << 16), __uint_as_float(v.x & 0xffff0000u), __uint_as_float(v.y << 16), __uint_as_float(v.y & 0xffff0000u)}; }
struct EpiResA {
    static constexpr bool PERM = true, AFTER_DRAIN = false;
    const float* res32; const bf16_t* res16; bf16_t* XBo; float* STAT;
    DI void operator()(const f32x4 (&acc)[2][2][4][2], const pg8::Unit& u, int wr, int wc, int fr, int fq) const {
        asm volatile("" : "+v"(fr), "+v"(fq));
        const int row0 = u.pm * 256 + wr * 64 + fr, col0 = u.pn * 256 + wc * 32 + 8 * fq, lane = fq * 16 + fr;
#pragma unroll
        for (int ai = 0; ai < 2; ++ai)
#pragma unroll
            for (int m = 0; m < 4; ++m) { const int row = row0 + ai * 128 + m * 16; const size_t off = (size_t)row * DMODEL + col0; float s = 0.f, q = 0.f;
#pragma unroll
                for (int bj = 0; bj < 2; ++bj) { float r[8];
                    if (res32) { const f32x4 r0 = *(const f32x4*)(res32 + off + bj * 128), r1 = *(const f32x4*)(res32 + off + bj * 128 + 4); r[0] = r0[0]; r[1] = r0[1]; r[2] = r0[2]; r[3] = r0[3]; r[4] = r1[0]; r[5] = r1[1]; r[6] = r1[2]; r[7] = r1[3]; }
                    else unpack8(*(const u32x4*)(res16 + off + bj * 128), r);
                    float o[8];
#pragma unroll
                    for (int k = 0; k < 8; ++k) { o[k] = r[k] * ALPHA + acc[ai][bj][m][k >> 2][k & 3]; s += o[k]; q += o[k] * o[k]; }
                    *(u32x4*)(XBo + off + bj * 128) = pack8(o); }
                s += bperm(s, lane ^ 16); q += bperm(q, lane ^ 16); s += bperm(s, lane ^ 32); q += bperm(q, lane ^ 32);
                if (fq == 0) *(f32x2*)(STAT + (size_t)row * 32 + (u.pn * 4 + wc) * 2) = (f32x2){s, q};
                if (m == 3) asm volatile("" ::: "memory"); }
    }
};
struct EpiResB {
    static constexpr bool PERM = true, AFTER_DRAIN = false;
    const bf16_t* XBin; bf16_t* XBout; float* out32; const float* STAT; const float* g; const float* b;
    DI void operator()(const f32x4 (&acc)[2][2][4][2], const pg8::Unit& u, int wr, int wc, int fr, int fq) const {
        asm volatile("" : "+v"(fr), "+v"(fq));
        const int row0 = u.pm * 256 + wr * 64 + fr, col0 = u.pn * 256 + wc * 32 + 8 * fq, lane = fq * 16 + fr;
#pragma unroll
        for (int ai = 0; ai < 2; ++ai)
#pragma unroll
            for (int m = 0; m < 4; ++m) { const int row = row0 + ai * 128 + m * 16; const size_t off = (size_t)row * DMODEL + col0; float mu, rstd; row_stats(STAT, row, fq, lane, mu, rstd);
#pragma unroll
                for (int bj = 0; bj < 2; ++bj) { float p[8]; unpack8(*(const u32x4*)(XBin + off + bj * 128), p);
                    const f32x4 g0 = *(const f32x4*)(g + col0 + bj * 128), g1 = *(const f32x4*)(g + col0 + bj * 128 + 4), b0 = *(const f32x4*)(b + col0 + bj * 128), b1 = *(const f32x4*)(b + col0 + bj * 128 + 4);
                    float o[8];
#pragma unroll
                    for (int k = 0; k < 8; ++k) { const float gg = k < 4 ? g0[k & 3] : g1[k & 3], bb = k < 4 ? b0[k & 3] : b1[k & 3]; const float x1 = (p[k] - mu) * rstd * gg + bb; o[k] = x1 * ALPHA + acc[ai][bj][m][k >> 2][k & 3]; }
                    if (out32) { *(f32x4*)(out32 + off + bj * 128) = (f32x4){o[0], o[1], o[2], o[3]}; *(f32x4*)(out32 + off + bj * 128 + 4) = (f32x4){o[4], o[5], o[6], o[7]}; }
                    else *(u32x4*)(XBout + off + bj * 128) = pack8(o); }
                if (m == 3) asm volatile("" ::: "memory"); }
    }
};
struct EpiSwiGLU {
    static constexpr bool PERM = true, AFTER_DRAIN = false;
    bf16_t* HID; const float* STAT; const float* C1; const float* C2;
    DI void operator()(const f32x4 (&acc)[2][2][4][2], const pg8::Unit& u, int wr, int wc, int fr, int fq) const {
        asm volatile("" : "+v"(fr), "+v"(fq));
        const int row0 = u.pm * 256 + wr * 64 + fr, col0 = u.pn * 128 + wc * 32 + 8 * fq, lane = fq * 16 + fr, cc = u.pn * 256 + wc * 32 + 8 * fq;
        f32x4 c1[2][2], c2[2][2];
#pragma unroll
        for (int bj = 0; bj < 2; ++bj)
#pragma unroll
            for (int n = 0; n < 2; ++n) { c1[bj][n] = *(const f32x4*)(C1 + cc + bj * 128 + n * 4); c2[bj][n] = *(const f32x4*)(C2 + cc + bj * 128 + n * 4); }
#pragma unroll
        for (int ai = 0; ai < 2; ++ai)
#pragma unroll
            for (int m = 0; m < 4; ++m) { const int row = row0 + ai * 128 + m * 16; float mu, rstd; row_stats(STAT, row, fq, lane, mu, rstd);
                const f32x4 g0 = (acc[ai][0][m][0] - c1[0][0] * mu) * rstd + c2[0][0], g1 = (acc[ai][0][m][1] - c1[0][1] * mu) * rstd + c2[0][1];
                const f32x4 u0 = (acc[ai][1][m][0] - c1[1][0] * mu) * rstd + c2[1][0], u1 = (acc[ai][1][m][1] - c1[1][1] * mu) * rstd + c2[1][1];
                u32x4 w; w.x = pk2(silu_f(g0[0]) * u0[0], silu_f(g0[1]) * u0[1]); w.y = pk2(silu_f(g0[2]) * u0[2], silu_f(g0[3]) * u0[3]);
                w.z = pk2(silu_f(g1[0]) * u1[0], silu_f(g1[1]) * u1[1]); w.w = pk2(silu_f(g1[2]) * u1[2], silu_f(g1[3]) * u1[3]);
                *(u32x4*)(HID + (size_t)row * DFF + col0) = w; }
    }
};

DI float wave_sum(float v, int lane) {
#pragma unroll
    for (int o = 1; o < 64; o <<= 1) v += bperm(v, lane ^ o);
    return v;
}
template <int MI, int NI>
DI void wgemm(f32x4 (&acc)[MI][NI], const LAS bf16_t* A, int pa, const LAS bf16_t* Bt, int pb, int K, int lane) {
    const int r = lane & 15, q = lane >> 4;
    const LAS bf16_t* ap = A + r * pa + q * 8; const LAS bf16_t* bp = Bt + r * pb + q * 8;
#pragma unroll 1
    for (int k = 0; k < K; k += 32) {
        bf16x8 a[MI], b[NI];
#pragma unroll
        for (int mi = 0; mi < MI; ++mi) a[mi] = *(const LAS bf16x8*)(ap + mi * 16 * pa + k);
#pragma unroll
        for (int ni = 0; ni < NI; ++ni) b[ni] = *(const LAS bf16x8*)(bp + ni * 16 * pb + k);
#pragma unroll
        for (int mi = 0; mi < MI; ++mi)
#pragma unroll
            for (int ni = 0; ni < NI; ++ni) acc[mi][ni] = __builtin_amdgcn_mfma_f32_16x16x32_bf16(a[mi], b[ni], acc[mi][ni], 0, 0, 0);
    }
}
template <int MI, int NI> DI void zero_acc(f32x4 (&acc)[MI][NI]) {
#pragma unroll
    for (int mi = 0; mi < MI; ++mi)
#pragma unroll
        for (int ni = 0; ni < NI; ++ni) acc[mi][ni] = (f32x4){0.f, 0.f, 0.f, 0.f};
}
DI void conv_load(const bf16_t* src, int s0, u32x4 (&raw)[7]) {
#pragma unroll
    for (int i = 0; i < 7; ++i) { const int s = s0 - 3 + i; raw[i] = (s >= 0) ? *(const u32x4*)(src + (size_t)s * HP) : (u32x4){0u, 0u, 0u, 0u}; }
}
template <bool SILU>
DI void conv_compute(const u32x4 (&raw)[7], const float* w, int C, const float* bias, float (&out)[4][8]) {
    float wv[4][8], bv[8], x[7][8];
#pragma unroll
    for (int j = 0; j < 4; ++j) { const f32x4 a = *(const f32x4*)(w + (size_t)j * C), b = *(const f32x4*)(w + (size_t)j * C + 4);
        wv[j][0] = a[0]; wv[j][1] = a[1]; wv[j][2] = a[2]; wv[j][3] = a[3]; wv[j][4] = b[0]; wv[j][5] = b[1]; wv[j][6] = b[2]; wv[j][7] = b[3]; }
    { const f32x4 a = *(const f32x4*)bias, b = *(const f32x4*)(bias + 4); bv[0] = a[0]; bv[1] = a[1]; bv[2] = a[2]; bv[3] = a[3]; bv[4] = b[0]; bv[5] = b[1]; bv[6] = b[2]; bv[7] = b[3]; }
#pragma unroll
    for (int i = 0; i < 7; ++i) unpack8(raw[i], x[i]);
#pragma unroll
    for (int t = 0; t < 4; ++t)
#pragma unroll
        for (int c = 0; c < 8; ++c) { float v = bv[c] + wv[0][c] * x[t][c] + wv[1][c] * x[t + 1][c] + wv[2][c] * x[t + 2][c] + wv[3][c] * x[t + 3][c]; out[t][c] = SILU ? silu_f(v) : v; }
}
template <bool SILU>
DI void conv8x4(const bf16_t* src, int s0, const float* w, int C, const float* bias, float (&out)[4][8]) { u32x4 raw[7]; conv_load(src, s0, raw); conv_compute<SILU>(raw, w, C, bias, out); }

struct LayerP {
    const float *g_q, *w_uq, *g_kv, *w_ukv, *ssd_cw, *ssd_cb, *ssd_dtb, *ssd_alog, *ssd_d, *ssd_ng, *ret_g, *ret_b, *lru_cw, *lru_cb, *lru_wa, *lru_ba, *lru_wx, *lru_bx, *lru_ap, *ln1g, *ln1b, *ln2g, *ln2b;
    const float *w_in, *w_out, *w_f1, *w_f2;
};
DI LayerP layer_params(KArgs ka, int l) {
    const Args a = *ka;
    LayerP p;
    p.w_in = a.in[2] + (size_t)l * DMODEL * NIN; p.g_q = a.in[3] + l * 256; p.w_uq = a.in[4] + (size_t)l * 256 * 192; p.g_kv = a.in[5] + l * 128; p.w_ukv = a.in[6] + (size_t)l * 128 * 384;
    p.ssd_cw = a.in[7] + l * 4 * 768; p.ssd_cb = a.in[8] + l * 768; p.ssd_dtb = a.in[9] + l * 4; p.ssd_alog = a.in[10] + l * 4; p.ssd_d = a.in[11] + l * 4; p.ssd_ng = a.in[12] + l * 256;
    p.ret_g = a.in[13] + l * 256; p.ret_b = a.in[14] + l * 256; p.lru_cw = a.in[15] + l * 4 * 256; p.lru_cb = a.in[16] + l * 256; p.lru_wa = a.in[17] + l * 16384; p.lru_ba = a.in[18] + l * 256;
    p.lru_wx = a.in[19] + l * 16384; p.lru_bx = a.in[20] + l * 256; p.lru_ap = a.in[21] + l * 256; p.w_out = a.in[22] + (size_t)l * 1024 * 1024; p.ln1g = a.in[23] + l * 1024; p.ln1b = a.in[24] + l * 1024;
    p.w_f1 = a.in[25] + (size_t)l * 1024 * 2 * DFF; p.w_f2 = a.in[26] + (size_t)l * DFF * 1024; p.ln2g = a.in[27] + l * 1024; p.ln2b = a.in[28] + l * 1024;
    return p;
}

template <class SrcCol>
DI void transpose_w(const float* W, int K, int Nsrc, bf16_t* WT, int Ndst, const float* gain, SrcCol sc, LAS float* scr, int gw, int NGW, int lane, int Kvalid = 1 << 30, const float* bias = nullptr, float* PART1 = nullptr, float* PART2 = nullptr) {
    const int nblk = Ndst / 32, nitems = (K / 64) * nblk;
    for (int it = gw; it < nitems; it += NGW) {
        const int kb = it / nblk, nb = it % nblk, k0 = 64 * kb, n0 = 32 * nb;
        const int src = sc(n0 + (lane & 31));
        float a1 = 0.f, a2 = 0.f;
#pragma unroll
        for (int i = 0; i < 32; ++i) { const int kk = 2 * i + (lane >> 5); float v = 0.f; if (src >= 0 && k0 + kk < Kvalid) { const float w = W[(size_t)(k0 + kk) * Nsrc + src]; v = gain ? w * gain[k0 + kk] : w; if (PART1) { a1 += bf2f(f2bf(v)); a2 += bias[k0 + kk] * w; } } scr[kk * 33 + (lane & 31)] = v; }
        if (PART1) { a1 += bperm(a1, lane ^ 32); a2 += bperm(a2, lane ^ 32); if (lane < 32) { PART1[(size_t)kb * Ndst + n0 + lane] = a1; PART2[(size_t)kb * Ndst + n0 + lane] = a2; } }
        asm volatile("s_waitcnt lgkmcnt(0)" ::: "memory");
        const int c = lane & 7;
#pragma unroll
        for (int j = 0; j < 4; ++j) { const int n = (lane >> 3) + 8 * j; const LAS float* s = scr + (8 * c) * 33 + n;
            u32x4 o; o.x = pk2(s[0 * 33], s[1 * 33]); o.y = pk2(s[2 * 33], s[3 * 33]); o.z = pk2(s[4 * 33], s[5 * 33]); o.w = pk2(s[6 * 33], s[7 * 33]);
            *(u32x4*)(WT + (size_t)(n0 + n) * K + k0 + 8 * c) = o; }
        asm volatile("s_waitcnt lgkmcnt(0)" ::: "memory");
    }
}
struct ScIn { DI int operator()(int n) const { return n < 1424 ? n : (n < 2960 ? n + 4 : (n < 2964 ? 1424 + (n - 2960) : -1)); } };
struct ScId { DI int operator()(int n) const { return n; } };
struct ScUq { DI int operator()(int n) const { const int h = n >> 6, e = n & 63; if (e < 32) return h * 48 + e; if (e >= 48) return -1; const int j = e - 32, fq = j >> 3, s = j & 7; return h * 48 + 32 + (s < 4 ? 4 * fq + s : 4 * fq + s + 4); } };
struct ScUkv { DI int operator()(int n) const { const int h = (n & 255) >> 6, e = n & 63; if (n < 256) return e < 32 ? h * 96 + e : -1; return h * 96 + 32 + e; } };
struct ScF1 { DI int operator()(int n) const { const int pn = n >> 8, x = n & 127; return (n & 128) ? DFF + 128 * pn + x : 128 * pn + x; } };

DI void convert_weights(const Args& a, int l, LAS unsigned char* lds, int wave, int lane) {
    const LayerP P = layer_params(kargs(), l);
    unsigned char* wb = a.ws + WS_W;
    LAS float* scr = (LAS float*)(lds + wave * 16384);
    const int gw0 = lbid() * 8 + wave, NGW = lgdim() * 8; int gw = gw0, base = 0;
#define NEXT_MAT(K_, N_) do { base = (base + ((K_) / 64) * ((N_) / 32)) % NGW; gw = gw0 - base; if (gw < 0) gw += NGW; } while (0)
    transpose_w(P.w_f1, 1024, 2 * DFF, (bf16_t*)(wb + W_F1), 2 * DFF, P.ln1g, ScF1(), scr, gw, NGW, lane, 1 << 30, P.ln1b, (float*)(wb + W_PART1), (float*)(wb + W_PART2));
    NEXT_MAT(1024, 2 * DFF);
    transpose_w(P.w_in, 1024, NIN, (bf16_t*)(wb + W_IN), HP, nullptr, ScIn(), scr, gw, NGW, lane);
    NEXT_MAT(1024, HP);
    transpose_w(P.w_f2, DFF, 1024, (bf16_t*)(wb + W_F2), 1024, nullptr, ScId(), scr, gw, NGW, lane);
    NEXT_MAT(DFF, 1024);
    transpose_w(P.w_out, 1024, 1024, (bf16_t*)(wb + W_OUT), 1024, nullptr, ScId(), scr, gw, NGW, lane);
    NEXT_MAT(1024, 1024);
    transpose_w(P.w_uq, 256, 192, (bf16_t*)(wb + W_UQ), 256, P.g_q, ScUq(), scr, gw, NGW, lane);
    NEXT_MAT(256, 256);
    transpose_w(P.w_ukv, 256, 384, (bf16_t*)(wb + W_UKV), 512, P.g_kv, ScUkv(), scr, gw, NGW, lane, 128);
    NEXT_MAT(256, 512);
    for (int m = 0; m < 8; ++m)
        { transpose_w((m < 4 ? P.lru_wa : P.lru_wx) + (m & 3) * 4096, 64, 64, (bf16_t*)(wb + W_LRU) + m * 4096, 64, nullptr, ScId(), scr, gw, NGW, lane); NEXT_MAT(64, 64); }
#undef NEXT_MAT
}

DI void ln_row(const float* xrow, const float* g, const float* b, float* orow, bf16_t* obf, int lane) {
    const f32x4* xr = (const f32x4*)xrow + lane;
    f32x4 v[4]; float s = 0.f;
#pragma unroll
    for (int j = 0; j < 4; ++j) { v[j] = xr[64 * j]; s += (v[j][0] + v[j][1]) + (v[j][2] + v[j][3]); }
    const float mean = wave_sum(s, lane) * (1.f / 1024.f); float s2 = 0.f;
#pragma unroll
    for (int j = 0; j < 4; ++j) { v[j] = v[j] - mean; s2 += (v[j][0] * v[j][0] + v[j][1] * v[j][1]) + (v[j][2] * v[j][2] + v[j][3] * v[j][3]); }
    const float rstd = 1.f / sqrtf(wave_sum(s2, lane) * (1.f / 1024.f) + EPS);
#pragma unroll
    for (int j = 0; j < 4; ++j) { const f32x4 gg = ((const f32x4*)g)[lane + 64 * j], bb = ((const f32x4*)b)[lane + 64 * j]; const f32x4 o = v[j] * rstd * gg + bb;
        ((f32x4*)orow)[lane + 64 * j] = o;
        if (obf) { u32x2 w; w.x = pk2(o[0], o[1]); w.y = pk2(o[2], o[3]); ((u32x2*)obf)[lane + 64 * j] = w; } }
}

DI void ln_rows2_bf16(bf16_t* xa, bf16_t* xb, const float* g, const float* b, int lane, bool two) {
    u32x4* xr[2] = {(u32x4*)xa, (u32x4*)xb}; float v[2][2][8]; float s[2] = {0.f, 0.f}, s2[2] = {0.f, 0.f}, mean[2], rstd[2];
    u32x4 raw[2][2];
#pragma unroll
    for (int r = 0; r < 2; ++r)
#pragma unroll
        for (int j = 0; j < 2; ++j) raw[r][j] = xr[r][lane + 64 * j];
#pragma unroll
    for (int r = 0; r < 2; ++r)
#pragma unroll
        for (int j = 0; j < 2; ++j) { unpack8(raw[r][j], v[r][j]);
#pragma unroll
            for (int k = 0; k < 8; ++k) s[r] += v[r][j][k]; }
#pragma unroll
    for (int o = 1; o < 64; o <<= 1) { s[0] += bperm(s[0], lane ^ o); s[1] += bperm(s[1], lane ^ o); }
#pragma unroll
    for (int r = 0; r < 2; ++r) { mean[r] = s[r] * (1.f / 1024.f);
#pragma unroll
        for (int j = 0; j < 2; ++j)
#pragma unroll
            for (int k = 0; k < 8; ++k) { v[r][j][k] -= mean[r]; s2[r] += v[r][j][k] * v[r][j][k]; } }
#pragma unroll
    for (int o = 1; o < 64; o <<= 1) { s2[0] += bperm(s2[0], lane ^ o); s2[1] += bperm(s2[1], lane ^ o); }
#pragma unroll
    for (int r = 0; r < 2; ++r) rstd[r] = 1.f / sqrtf(s2[r] * (1.f / 1024.f) + EPS);
#pragma unroll
    for (int j = 0; j < 2; ++j) { const int c0 = (lane + 64 * j) * 8; const f32x4 g0 = *(const f32x4*)(g + c0), g1 = *(const f32x4*)(g + c0 + 4), b0 = *(const f32x4*)(b + c0), b1 = *(const f32x4*)(b + c0 + 4);
#pragma unroll
        for (int r = 0; r < 2; ++r) { float o[8];
#pragma unroll
            for (int k = 0; k < 4; ++k) { o[k] = v[r][j][k] * rstd[r] * g0[k] + b0[k]; o[4 + k] = v[r][j][4 + k] * rstd[r] * g1[k] + b1[k]; }
            if (r == 0 || two) xr[r][lane + 64 * j] = pack8(o); } }
}
DI void ln_rows2_bf16_f32(const bf16_t* xa, const bf16_t* xb, float* oa, float* ob, const float* g, const float* b, int lane, bool two) {
    const u32x4* xr[2] = {(const u32x4*)xa, (const u32x4*)xb}; float* orow[2] = {oa, ob}; float v[2][2][8]; float s[2] = {0.f, 0.f}, s2[2] = {0.f, 0.f}, mean[2], rstd[2];
    u32x4 raw[2][2];
#pragma unroll
    for (int r = 0; r < 2; ++r)
#pragma unroll
        for (int j = 0; j < 2; ++j) raw[r][j] = xr[r][lane + 64 * j];
#pragma unroll
    for (int r = 0; r < 2; ++r)
#pragma unroll
        for (int j = 0; j < 2; ++j) { unpack8(raw[r][j], v[r][j]);
#pragma unroll
            for (int k = 0; k < 8; ++k) s[r] += v[r][j][k]; }
#pragma unroll
    for (int o = 1; o < 64; o <<= 1) { s[0] += bperm(s[0], lane ^ o); s[1] += bperm(s[1], lane ^ o); }
#pragma unroll
    for (int r = 0; r < 2; ++r) { mean[r] = s[r] * (1.f / 1024.f);
#pragma unroll
        for (int j = 0; j < 2; ++j)
#pragma unroll
            for (int k = 0; k < 8; ++k) { v[r][j][k] -= mean[r]; s2[r] += v[r][j][k] * v[r][j][k]; } }
#pragma unroll
    for (int o = 1; o < 64; o <<= 1) { s2[0] += bperm(s2[0], lane ^ o); s2[1] += bperm(s2[1], lane ^ o); }
#pragma unroll
    for (int r = 0; r < 2; ++r) rstd[r] = 1.f / sqrtf(s2[r] * (1.f / 1024.f) + EPS);
#pragma unroll
    for (int j = 0; j < 2; ++j) { const int c0 = (lane + 64 * j) * 8; const f32x4 g0 = *(const f32x4*)(g + c0), g1 = *(const f32x4*)(g + c0 + 4), b0 = *(const f32x4*)(b + c0), b1 = *(const f32x4*)(b + c0 + 4);
#pragma unroll
        for (int r = 0; r < 2; ++r) if (r == 0 || two) { f32x4 o0, o1;
#pragma unroll
            for (int k = 0; k < 4; ++k) { o0[k] = v[r][j][k] * rstd[r] * g0[k] + b0[k]; o1[k] = v[r][j][4 + k] * rstd[r] * g1[k] + b1[k]; }
            *(f32x4*)(orow[r] + c0) = o0; *(f32x4*)(orow[r] + c0 + 4) = o1; } }
}
DI void ln_rows2_f32(float* xa, float* xb, const float* g, const float* b, int lane, bool two) {
    f32x4* xr[2] = {(f32x4*)xa, (f32x4*)xb}; f32x4 v[2][4]; float s[2] = {0.f, 0.f}, s2[2] = {0.f, 0.f}, mean[2], rstd[2];
#pragma unroll
    for (int r = 0; r < 2; ++r)
#pragma unroll
        for (int j = 0; j < 4; ++j) v[r][j] = xr[r][lane + 64 * j];
#pragma unroll
    for (int r = 0; r < 2; ++r)
#pragma unroll
        for (int j = 0; j < 4; ++j) s[r] += (v[r][j][0] + v[r][j][1]) + (v[r][j][2] + v[r][j][3]);
#pragma unroll
    for (int o = 1; o < 64; o <<= 1) { s[0] += bperm(s[0], lane ^ o); s[1] += bperm(s[1], lane ^ o); }
#pragma unroll
    for (int r = 0; r < 2; ++r) { mean[r] = s[r] * (1.f / 1024.f);
#pragma unroll
        for (int j = 0; j < 4; ++j) { v[r][j] = v[r][j] - mean[r]; s2[r] += (v[r][j][0] * v[r][j][0] + v[r][j][1] * v[r][j][1]) + (v[r][j][2] * v[r][j][2] + v[r][j][3] * v[r][j][3]); } }
#pragma unroll
    for (int o = 1; o < 64; o <<= 1) { s2[0] += bperm(s2[0], lane ^ o); s2[1] += bperm(s2[1], lane ^ o); }
#pragma unroll
    for (int r = 0; r < 2; ++r) rstd[r] = 1.f / sqrtf(s2[r] * (1.f / 1024.f) + EPS);
#pragma unroll
    for (int j = 0; j < 4; ++j) { const f32x4 gg = ((const f32x4*)g)[lane + 64 * j], bb = ((const f32x4*)b)[lane + 64 * j];
#pragma unroll
        for (int r = 0; r < 2; ++r) if (r == 0 || two) xr[r][lane + 64 * j] = v[r][j] * rstd[r] * gg + bb; }
}

constexpr int PT = 136;
DI void ssd_acs(const float* DT, const LayerP& P, int row0, int h, LAS float* acs, LAS float* dtl, int lane) {
    const float bias = P.ssd_dtb[h], A = -__expf(P.ssd_alog[h]);
    const float d0 = softplus_f(DT[(size_t)(row0 + 2 * lane) * 4 + h] + bias), d1 = softplus_f(DT[(size_t)(row0 + 2 * lane + 1) * 4 + h] + bias);
    const float a0 = d0 * A, a1 = d1 * A; float incl = a0 + a1;
#pragma unroll
    for (int o = 1; o < 64; o <<= 1) { const float t = bperm(incl, lane - o); if (lane >= o) incl += t; }
    const float excl = incl - (a0 + a1);
    acs[2 * lane] = excl + a0; acs[2 * lane + 1] = incl; dtl[2 * lane] = d0; dtl[2 * lane + 1] = d1;
}
DI void ssd_pass1(LAS unsigned char* lds, const Args& a, const LayerP& P, int unit, int wv) {
    const int tid = ltid(wv), lane = tid & 63, wave = wv;
    const int c = unit & (NCH - 1), b = unit >> 7, row0 = b * SEQ + c * 128;
    const bf16_t* Hb = (const bf16_t*)(a.ws + WS_H) + (size_t)b * SEQ * HP;
    LAS bf16_t* BT = (LAS bf16_t*)lds; LAS bf16_t* XT = (LAS bf16_t*)(lds + 69632); LAS float* acs = (LAS float*)(lds + 139264); LAS float* dtl = (LAS float*)(lds + 141312);
    const int cv = tid & 15, t0 = (tid >> 4) * 4;
    u32x4 rawX[2][7], rawB[2][7];
#pragma unroll
    for (int g = 0; g < 2; ++g) { conv_load(Hb + C_XBC + g * 128 + cv * 8, c * 128 + t0, rawX[g]); conv_load(Hb + C_XBC + 256 + g * 128 + cv * 8, c * 128 + t0, rawB[g]); }
    __syncthreads();
    if (wave < 4) ssd_acs((const float*)(a.ws + WS_DT), P, row0, wave, acs + wave * 128, dtl + wave * 128, lane);
    __syncthreads();
#pragma unroll
    for (int g = 0; g < 2; ++g) {
        { float o[4][8]; conv_compute<true>(rawX[g], P.ssd_cw + g * 128 + cv * 8, 768, P.ssd_cb + g * 128 + cv * 8, o);
          const int h = 2 * g + (cv >> 3); const float ae = acs[h * 128 + 127]; float w[4];
#pragma unroll
          for (int t = 0; t < 4; ++t) w[t] = __expf(ae - acs[h * 128 + t0 + t]) * dtl[h * 128 + t0 + t];
#pragma unroll
          for (int k = 0; k < 8; ++k) { u32x2 v; v.x = pk2(o[0][k] * w[0], o[1][k] * w[1]); v.y = pk2(o[2][k] * w[2], o[3][k] * w[3]); *(LAS u32x2*)(XT + (h * 64 + (cv & 7) * 8 + k) * PT + t0) = v; } }
        { float o[4][8]; conv_compute<true>(rawB[g], P.ssd_cw + 256 + g * 128 + cv * 8, 768, P.ssd_cb + 256 + g * 128 + cv * 8, o);
#pragma unroll
          for (int k = 0; k < 8; ++k) { u32x2 v; v.x = pk2(o[0][k], o[1][k]); v.y = pk2(o[2][k], o[3][k]); *(LAS u32x2*)(BT + (g * 128 + cv * 8 + k) * PT + t0) = v; } }
    }
    __syncthreads();
    const int h = wave >> 1, nb = (wave & 1) * 64, r = lane & 15, q = lane >> 4;
    f32x4 acc[4][4]; zero_acc(acc);
    wgemm<4, 4>(acc, BT + ((h >> 1) * 128 + nb) * PT, PT, XT + h * 64 * PT, PT, 128, lane);
    float* ST = (float*)((unsigned char*)a.out + DO_ST) + ((size_t)((b * NCH + c) * 4 + h)) * 8192;
#pragma unroll
    for (int mi = 0; mi < 4; ++mi)
#pragma unroll
        for (int ni = 0; ni < 4; ++ni) *(f32x4*)(ST + (ni * 16 + r) * 128 + nb + mi * 16 + 4 * q) = acc[mi][ni];
    if (tid < 4) ((float*)(a.ws + WS_SDEC))[(b * NCH + c) * 4 + tid] = __expf(acs[tid * 128 + 127]);
}
DI void ssd_pass2(LAS unsigned char* lds, const Args& a, const LayerP& P, int unit, int wv) {
    const int wave = wv;
    const int c = unit & (NCH - 1), b = unit >> 7, row0 = b * SEQ + c * 128;
    const bf16_t* Hg = (const bf16_t*)(a.ws + WS_H);
    const bf16_t* Hb = Hg + (size_t)b * SEQ * HP;
    LAS bf16_t* Cm = (LAS bf16_t*)lds; LAS bf16_t* R1 = (LAS bf16_t*)(lds + 34816); LAS bf16_t* Mw = (LAS bf16_t*)(lds + 69632 + wave * 8704);
    LAS float* acs = (LAS float*)(lds + 139264); LAS float* dtl = (LAS float*)(lds + 140288); LAS float* rowss = (LAS float*)(lds + 141312);
    const int hh = wave >> 2, lr = (wave & 3) * 32;
    float* YT = (float*)(a.ws + WS_YT);
#pragma unroll 1
    for (int g = 0; g < 2; ++g) {
        const int tid = ltid(wv), lane = tid & 63, cv = tid & 15, t0 = (tid >> 4) * 4, r = lane & 15, q = lane >> 4;
        __syncthreads();
        if (wave < 2) ssd_acs((const float*)(a.ws + WS_DT), P, row0, 2 * g + wave, acs + wave * 128, dtl + wave * 128, lane);
        { float o[4][8]; conv8x4<true>(Hb + C_XBC + 512 + g * 128 + cv * 8, c * 128 + t0, P.ssd_cw + 512 + g * 128 + cv * 8, 768, P.ssd_cb + 512 + g * 128 + cv * 8, o);
#pragma unroll
          for (int t = 0; t < 4; ++t) *(LAS u32x4*)(Cm + (t0 + t) * PT + cv * 8) = pack8(o[t]); }
        { const float* ST = (const float*)((const unsigned char*)a.out + DO_ST) + ((size_t)((b * NCH + c) * 4 + 2 * g)) * 8192;
#pragma unroll
          for (int i = 0; i < 8; ++i) { const int e4 = (i * 512 + tid) * 4; const f32x4 v = *(const f32x4*)(ST + e4); u32x2 w; w.x = pk2(v[0], v[1]); w.y = pk2(v[2], v[3]);
              *(LAS u32x2*)(R1 + (e4 >> 7) * PT + (e4 & 127)) = w; } }
        u32x4 rawB[7]; conv_load(Hb + C_XBC + 256 + g * 128 + cv * 8, c * 128 + t0, rawB);
        __syncthreads();
        f32x4 acc[4][2]; zero_acc(acc);
        wgemm<4, 2>(acc, R1 + hh * 64 * PT, PT, Cm + lr * PT, PT, 128, lane);
#pragma unroll
        for (int ni = 0; ni < 2; ++ni) { const float e = __expf(acs[hh * 128 + lr + ni * 16 + r]);
#pragma unroll
            for (int mi = 0; mi < 4; ++mi) acc[mi][ni] = acc[mi][ni] * e; }
        __syncthreads();
        { float o[4][8]; conv_compute<true>(rawB, P.ssd_cw + 256 + g * 128 + cv * 8, 768, P.ssd_cb + 256 + g * 128 + cv * 8, o);
#pragma unroll
          for (int t = 0; t < 4; ++t) *(LAS u32x4*)(R1 + (t0 + t) * PT + cv * 8) = pack8(o[t]); }
        u32x4 rawX[7]; conv_load(Hb + C_XBC + g * 128 + cv * 8, c * 128 + t0, rawX);
        __syncthreads();
#pragma unroll 1
        for (int sh = 0; sh < 2; ++sh) { f32x4 gacc[2][4]; zero_acc(gacc);
          wgemm<2, 4>(gacc, Cm + lr * PT, PT, R1 + sh * 64 * PT, PT, 128, lane);
#pragma unroll
          for (int mi = 0; mi < 2; ++mi)
#pragma unroll
              for (int j = 0; j < 4; ++j) { const int ll = mi * 16 + 4 * q + j, l = lr + ll; const float al = acs[hh * 128 + l];
#pragma unroll
                  for (int ni = 0; ni < 4; ++ni) { const int s = sh * 64 + ni * 16 + r; const float v = (s <= l) ? gacc[mi][ni][j] * __expf(al - acs[hh * 128 + s]) * dtl[hh * 128 + s] : 0.f; Mw[ll * PT + s] = f2bf(v); } } }
        __syncthreads();
        { float o[4][8]; conv_compute<true>(rawX, P.ssd_cw + g * 128 + cv * 8, 768, P.ssd_cb + g * 128 + cv * 8, o);
#pragma unroll
          for (int k = 0; k < 8; ++k) { u32x2 v; v.x = pk2(o[0][k], o[1][k]); v.y = pk2(o[2][k], o[3][k]); *(LAS u32x2*)(R1 + ((cv >> 3) * 64 + (cv & 7) * 8 + k) * PT + t0) = v; } }
        __syncthreads();
        const int h = 2 * g + hh; const float dsk = P.ssd_d[h];
        u32x2 zr[2][4];
#pragma unroll
        for (int ni = 0; ni < 2; ++ni)
#pragma unroll
            for (int mi = 0; mi < 4; ++mi) zr[ni][mi] = *(const u32x2*)(Hg + (size_t)(row0 + lr + ni * 16 + r) * HP + C_Z + h * 64 + mi * 16 + 4 * q);
        wgemm<4, 2>(acc, R1 + hh * 64 * PT, PT, Mw, PT, 128, lane);
#pragma unroll
        for (int ni = 0; ni < 2; ++ni) { const int l = lr + ni * 16 + r; float ss = 0.f;
#pragma unroll
            for (int mi = 0; mi < 4; ++mi) { const int p0 = mi * 16 + 4 * q; const f32x4 z = bf4_to_f32(zr[ni][mi]); f32x4 y;
#pragma unroll
                for (int j = 0; j < 4; ++j) { const float xs = bf2f(R1[(hh * 64 + p0 + j) * PT + l]); y[j] = (acc[mi][ni][j] + xs * dsk) * silu_f(z[j]); ss += y[j] * y[j]; }
                *(f32x4*)(YT + (size_t)(row0 + l) * 256 + h * 64 + p0) = y; }
            ss += bperm(ss, lane ^ 16); ss += bperm(ss, lane ^ 32);
            if (q == 0) rowss[h * 128 + l] = ss; }
    }
    __syncthreads();
    bf16_t* Y = (bf16_t*)(a.ws + WS_Y);
#pragma unroll 1
    for (int g = 0; g < 2; ++g) { const int lane = ltid(wv) & 63, r = lane & 15, q = lane >> 4, h = 2 * g + hh;
#pragma unroll
        for (int ni = 0; ni < 2; ++ni) { const int l = lr + ni * 16 + r;
            const float rs = __builtin_amdgcn_rsqf(((rowss[l] + rowss[128 + l]) + (rowss[256 + l] + rowss[384 + l])) * (1.0f / 256.0f) + EPS);
#pragma unroll
            for (int mi = 0; mi < 4; ++mi) { const int p0 = mi * 16 + 4 * q; const f32x4 y = *(const f32x4*)(YT + (size_t)(row0 + l) * 256 + h * 64 + p0), ng = *(const f32x4*)(P.ssd_ng + h * 64 + p0);
                u32x2 w; w.x = pk2(y[0] * rs * ng[0], y[1] * rs * ng[1]); w.y = pk2(y[2] * rs * ng[2], y[3] * rs * ng[3]);
                *(u32x2*)(Y + (size_t)(row0 + l) * DMODEL + 256 + h * 64 + p0) = w; } } }
}

constexpr int PQ = 72;
DI float ret_lg(int h) { return log1pf(-exp2f(-5.0f - (float)h)); }
template <int MODE>
DI void ret_stage(const Args& a, int row0, int h, float lg, LAS bf16_t* Qs, LAS bf16_t* Ks, LAS bf16_t* VT, LAS bf16_t* KT, int tid) {
    const bf16_t* Hg = (const bf16_t*)(a.ws + WS_H); const float* tab = (const float*)(a.ws + WS_ROPE64);
    const int t = tid >> 2, part = tid & 3, row = row0 + t; const bf16_t* hr = Hg + (size_t)row * HP;
    float cs[16]; { const f32x4* tp = (const f32x4*)(tab + (size_t)row * 64 + part * 16);
#pragma unroll
        for (int i = 0; i < 4; ++i) { const f32x4 v = tp[i]; cs[4 * i] = v[0]; cs[4 * i + 1] = v[1]; cs[4 * i + 2] = v[2]; cs[4 * i + 3] = v[3]; } }
    { float k1[8], k2[8], o1[8], o2[8]; unpack8(*(const u32x4*)(hr + C_RK + h * 64 + part * 8), k1); unpack8(*(const u32x4*)(hr + C_RK + h * 64 + 32 + part * 8), k2);
      const float sc = 0.125f * (MODE == 0 ? __expf(lg * (float)(127 - t)) : 1.0f);
#pragma unroll
      for (int i = 0; i < 8; ++i) { o1[i] = (k1[i] * cs[2 * i] - k2[i] * cs[2 * i + 1]) * sc; o2[i] = (k1[i] * cs[2 * i + 1] + k2[i] * cs[2 * i]) * sc; }
      if (MODE == 0) {
#pragma unroll
          for (int i = 0; i < 8; ++i) { KT[(part * 8 + i) * PT + t] = f2bf(o1[i]); KT[(32 + part * 8 + i) * PT + t] = f2bf(o2[i]); } }
      else { *(LAS u32x4*)(Ks + t * PQ + part * 8) = pack8(o1); *(LAS u32x4*)(Ks + t * PQ + 32 + part * 8) = pack8(o2); } }
    if (MODE == 1) { float q1[8], q2[8], o1[8], o2[8]; unpack8(*(const u32x4*)(hr + C_RQ + h * 64 + part * 8), q1); unpack8(*(const u32x4*)(hr + C_RQ + h * 64 + 32 + part * 8), q2);
#pragma unroll
      for (int i = 0; i < 8; ++i) { o1[i] = q1[i] * cs[2 * i] - q2[i] * cs[2 * i + 1]; o2[i] = q1[i] * cs[2 * i + 1] + q2[i] * cs[2 * i]; }
      *(LAS u32x4*)(Qs + t * PQ + part * 8) = pack8(o1); *(LAS u32x4*)(Qs + t * PQ + 32 + part * 8) = pack8(o2); }
    { float v[8]; unpack8(*(const u32x4*)(hr + C_RV + h * 64 + part * 16), v);
#pragma unroll
      for (int i = 0; i < 8; ++i) VT[(part * 16 + i) * PT + t] = f2bf(v[i]);
      unpack8(*(const u32x4*)(hr + C_RV + h * 64 + part * 16 + 8), v);
#pragma unroll
      for (int i = 0; i < 8; ++i) VT[(part * 16 + 8 + i) * PT + t] = f2bf(v[i]); }
}
struct RetRaw { f32x4 cs[4]; u32x4 k1, k2, q1, q2, v0, v1; f32x4 rs[2]; };
DI void ret_load(const Args& a, int row0, int h, int bc, int tid, RetRaw& R) {
    const bf16_t* Hg = (const bf16_t*)(a.ws + WS_H); const float* tab = (const float*)(a.ws + WS_ROPE64);
    const int t = tid >> 2, part = tid & 3, row = row0 + t; const bf16_t* hr = Hg + (size_t)row * HP;
    const f32x4* tp = (const f32x4*)(tab + (size_t)row * 64 + part * 16);
#pragma unroll
    for (int i = 0; i < 4; ++i) R.cs[i] = tp[i];
    R.k1 = *(const u32x4*)(hr + C_RK + h * 64 + part * 8); R.k2 = *(const u32x4*)(hr + C_RK + h * 64 + 32 + part * 8);
    R.q1 = *(const u32x4*)(hr + C_RQ + h * 64 + part * 8); R.q2 = *(const u32x4*)(hr + C_RQ + h * 64 + 32 + part * 8);
    R.v0 = *(const u32x4*)(hr + C_RV + h * 64 + part * 16); R.v1 = *(const u32x4*)(hr + C_RV + h * 64 + part * 16 + 8);
    const float* RS = (const float*)((const unsigned char*)a.out + DO_RS) + ((size_t)(bc * 4 + h)) * 4096;
#pragma unroll
    for (int i = 0; i < 2; ++i) R.rs[i] = *(const f32x4*)(RS + (i * 512 + tid) * 4);
}
DI void ret_write(const RetRaw& R, LAS bf16_t* Qs, LAS bf16_t* Ks, LAS bf16_t* VT, LAS bf16_t* STt, int tid) {
    const int t = tid >> 2, part = tid & 3;
    float cs[16];
#pragma unroll
    for (int i = 0; i < 4; ++i) { cs[4 * i] = R.cs[i][0]; cs[4 * i + 1] = R.cs[i][1]; cs[4 * i + 2] = R.cs[i][2]; cs[4 * i + 3] = R.cs[i][3]; }
    { float k1[8], k2[8], o1[8], o2[8]; unpack8(R.k1, k1); unpack8(R.k2, k2);
#pragma unroll
      for (int i = 0; i < 8; ++i) { o1[i] = (k1[i] * cs[2 * i] - k2[i] * cs[2 * i + 1]) * 0.125f; o2[i] = (k1[i] * cs[2 * i + 1] + k2[i] * cs[2 * i]) * 0.125f; }
      *(LAS u32x4*)(Ks + t * PQ + part * 8) = pack8(o1); *(LAS u32x4*)(Ks + t * PQ + 32 + part * 8) = pack8(o2); }
    { float q1[8], q2[8], o1[8], o2[8]; unpack8(R.q1, q1); unpack8(R.q2, q2);
#pragma unroll
      for (int i = 0; i < 8; ++i) { o1[i] = q1[i] * cs[2 * i] - q2[i] * cs[2 * i + 1]; o2[i] = q1[i] * cs[2 * i + 1] + q2[i] * cs[2 * i]; }
      *(LAS u32x4*)(Qs + t * PQ + part * 8) = pack8(o1); *(LAS u32x4*)(Qs + t * PQ + 32 + part * 8) = pack8(o2); }
    { float v[8]; unpack8(R.v0, v);
#pragma unroll
      for (int i = 0; i < 8; ++i) VT[(part * 16 + i) * PT + t] = f2bf(v[i]);
      unpack8(R.v1, v);
#pragma unroll
      for (int i = 0; i < 8; ++i) VT[(part * 16 + 8 + i) * PT + t] = f2bf(v[i]); }
#pragma unroll
    for (int i = 0; i < 2; ++i) { const int e4 = (i * 512 + tid) * 4; const f32x4 v = R.rs[i]; u32x2 w; w.x = pk2(v[0], v[1]); w.y = pk2(v[2], v[3]); *(LAS u32x2*)(STt + (e4 >> 6) * PQ + (e4 & 63)) = w; }
}
DI void ret_pass1(LAS unsigned char* lds, const Args& a, int unit, int wv) {
    const int wave = wv, c = unit & (NCH - 1), b = unit >> 7, row0 = b * SEQ + c * 128;
    const int tid = ltid(wv), lane = tid & 63, r = lane & 15, q = lane >> 4;
    __syncthreads();
#pragma unroll
    for (int h = 0; h < 4; ++h) ret_stage<0>(a, row0, h, ret_lg(h), nullptr, nullptr, (LAS bf16_t*)(lds + h * 34816), (LAS bf16_t*)(lds + h * 34816 + 17408), tid);
    __syncthreads();
    const int h = wave >> 1, e0 = (wave & 1) * 32;
    LAS bf16_t* VT = (LAS bf16_t*)(lds + h * 34816); LAS bf16_t* KT = (LAS bf16_t*)(lds + h * 34816 + 17408);
    f32x4 acc[4][2]; zero_acc(acc);
    wgemm<4, 2>(acc, KT, PT, VT + e0 * PT, PT, 128, lane);
    float* RS = (float*)((unsigned char*)a.out + DO_RS) + ((size_t)((b * NCH + c) * 4 + h)) * 4096;
#pragma unroll
    for (int mi = 0; mi < 4; ++mi)
#pragma unroll
        for (int ni = 0; ni < 2; ++ni) *(f32x4*)(RS + (e0 + ni * 16 + r) * 64 + mi * 16 + 4 * q) = acc[mi][ni];
}
DI void ret_pass2(LAS unsigned char* lds, const Args& a, const LayerP& P, int unit, int wv) {
    const int wave = wv, c = unit & (NCH - 1), b = unit >> 7, row0 = b * SEQ + c * 128, i0 = wave * 16;
    LAS bf16_t* Qs = (LAS bf16_t*)lds; LAS bf16_t* Ks = (LAS bf16_t*)(lds + 18432); LAS bf16_t* VT = (LAS bf16_t*)(lds + 36864); LAS bf16_t* STt = (LAS bf16_t*)(lds + 54272);
    LAS bf16_t* Pw = (LAS bf16_t*)(lds + 63488 + wave * 4352);
    const bf16_t* Hg = (const bf16_t*)(a.ws + WS_H); bf16_t* Y = (bf16_t*)(a.ws + WS_Y);
    RetRaw R; ret_load(a, row0, 0, b * NCH + c, ltid(wv), R);
#pragma unroll 1
    for (int h = 0; h < 4; ++h) {
        const int tid = ltid(wv), lane = tid & 63, r = lane & 15, q = lane >> 4;
        const float lg = ret_lg(h);
        __syncthreads();
        ret_write(R, Qs, Ks, VT, STt, tid);
        if (h < 3) ret_load(a, row0, h + 1, b * NCH + c, tid, R);
        __syncthreads();
        { f32x4 sacc[1][8]; zero_acc(sacc);
          wgemm<1, 8>(sacc, Qs + i0 * PQ, PQ, Ks, PQ, 64, lane);
#pragma unroll
          for (int j = 0; j < 4; ++j) { const int ii = 4 * q + j, i = i0 + ii;
#pragma unroll
              for (int ni = 0; ni < 8; ++ni) { const int jj = ni * 16 + r; const float v = (i >= jj) ? sacc[0][ni][j] * __expf(lg * (float)(i - jj)) : 0.f; Pw[ii * PT + jj] = f2bf(v); } } }
        __syncthreads();
        u32x2 gr[4];
#pragma unroll
        for (int mi = 0; mi < 4; ++mi) gr[mi] = *(const u32x2*)(Hg + (size_t)(row0 + i0 + r) * HP + C_RG + h * 64 + mi * 16 + 4 * q);
        f32x4 oacc[4][1], cacc[4][1]; zero_acc(oacc); zero_acc(cacc);
        wgemm<4, 1>(oacc, VT, PT, Pw, PT, 128, lane);
        wgemm<4, 1>(cacc, STt, PQ, Qs + i0 * PQ, PQ, 64, lane);
        { const int i = i0 + r; const float qd = __expf(lg * (float)(i + 1)); f32x4 o[4]; float s = 0.f;
#pragma unroll
          for (int mi = 0; mi < 4; ++mi) { o[mi] = oacc[mi][0] + cacc[mi][0] * qd; s += (o[mi][0] + o[mi][1]) + (o[mi][2] + o[mi][3]); }
          s += bperm(s, lane ^ 16); s += bperm(s, lane ^ 32);
          const float mu = s * (1.0f / 64.0f); float v2 = 0.f;
#pragma unroll
          for (int mi = 0; mi < 4; ++mi) { o[mi] = o[mi] - mu; v2 += (o[mi][0] * o[mi][0] + o[mi][1] * o[mi][1]) + (o[mi][2] * o[mi][2] + o[mi][3] * o[mi][3]); }
          v2 += bperm(v2, lane ^ 16); v2 += bperm(v2, lane ^ 32);
          const float rs = __builtin_amdgcn_rsqf(v2 * (1.0f / 64.0f) + EPS);
#pragma unroll
          for (int mi = 0; mi < 4; ++mi) { const int ch = h * 64 + mi * 16 + 4 * q; const f32x4 gt = bf4_to_f32(gr[mi]);
              const f32x4 gg = *(const f32x4*)(P.ret_g + ch), bb = *(const f32x4*)(P.ret_b + ch); const f32x4 y = o[mi] * rs * gg + bb;
              u32x2 w; w.x = pk2(silu_f(gt[0]) * y[0], silu_f(gt[1]) * y[1]); w.y = pk2(silu_f(gt[2]) * y[2], silu_f(gt[3]) * y[3]);
              *(u32x2*)(Y + (size_t)(row0 + i) * DMODEL + 512 + ch) = w; } }
    }
}

constexpr int PU = 264;
template <bool OUT>
DI void lru_sweep(LAS bf16_t* U, LAS float* SUM, const Args& a, const LayerP& P, int row0, int wv, const float* LC, f32x2* LSWc) {
    const int wave = wv, l0 = wave * 16;
    const bf16_t* LWT = (const bf16_t*)(a.ws + WS_W + W_LRU); const bf16_t* Hg = (const bf16_t*)(a.ws + WS_H); bf16_t* Y = (bf16_t*)(a.ws + WS_Y);
#pragma unroll 1
    for (int g = 0; g < 4; ++g) {
        const int lane = ltid(wv) & 63, r = lane & 15, q = lane >> 4;
        bf16x8 af[2];
#pragma unroll
        for (int ks = 0; ks < 2; ++ks) af[ks] = *(const LAS bf16x8*)(U + (l0 + r) * PU + g * 64 + ks * 32 + q * 8);
#pragma unroll
        for (int ni = 0; ni < 4; ++ni) { f32x4 aa1 = (f32x4){0.f, 0.f, 0.f, 0.f}, ax1 = aa1;
#pragma unroll
            for (int ks = 0; ks < 2; ++ks) { const bf16x8 wa = *(const bf16x8*)(LWT + ((size_t)(g * 64 + ni * 16 + r)) * 64 + ks * 32 + q * 8), wx = *(const bf16x8*)(LWT + ((size_t)((4 + g) * 64 + ni * 16 + r)) * 64 + ks * 32 + q * 8);
                aa1 = __builtin_amdgcn_mfma_f32_16x16x32_bf16(af[ks], wa, aa1, 0, 0, 0); ax1 = __builtin_amdgcn_mfma_f32_16x16x32_bf16(af[ks], wx, ax1, 0, 0, 0); }
            const int ch = g * 64 + ni * 16 + r; const float ba = P.lru_ba[ch], bx = P.lru_bx[ch], c8 = -8.0f * softplus_f(-P.lru_ap[ch]);
            float Pi[4], Ei[4], Pc = 1.f, Ec = 0.f;
#pragma unroll
            for (int j = 0; j < 4; ++j) { const float rg = sigmoid_f(aa1[j] + ba), ig = sigmoid_f(ax1[j] + bx); const float la = c8 * rg, av = __expf(la);
                const float u = bf2f(U[(l0 + 4 * q + j) * PU + ch]); const float inp = __builtin_amdgcn_sqrtf(one_minus_exp(2.0f * la)) * (ig * u);
                if (!OUT) ((unsigned*)(a.ws + WS_LA))[(size_t)(row0 + l0 + 4 * q + j) * 256 + ch] = pk2(one_minus_exp(la), inp);
                Ec = av * Ec + inp; Pc = Pc * av; Pi[j] = Pc; Ei[j] = Ec; }
            float Pp = 1.f, Ep = 0.f;
#pragma unroll
            for (int qq = 0; qq < 3; ++qq) { const float Pq = bperm(Pc, r + 16 * qq), Eq = bperm(Ec, r + 16 * qq); if (qq < q) { Ep = Pq * Ep + Eq; Pp = Pp * Pq; } }
#pragma unroll
            for (int j = 0; j < 4; ++j) { Ei[j] = Pi[j] * Ep + Ei[j]; Pi[j] = Pp * Pi[j]; }
            if (!OUT) { if (q == 3) { SUM[(wave * 256 + ch) * 2] = Pi[3]; SUM[(wave * 256 + ch) * 2 + 1] = Ei[3]; LSWc[wave * 256 + ch] = (f32x2){Pi[3], Ei[3]}; } }
            else { float hp = LC[ch];
                { f32x2 t[7];
#pragma unroll
                  for (int w = 0; w < 7; ++w) if (w < wave) t[w] = LSWc[w * 256 + ch];
#pragma unroll
                  for (int w = 0; w < 7; ++w) if (w < wave) hp = t[w][0] * hp + t[w][1]; }
#pragma unroll
                for (int j = 0; j < 4; ++j) { const int row = row0 + l0 + 4 * q + j; const float hv = Pi[j] * hp + Ei[j]; const float gt = bf2f(Hg[(size_t)row * HP + C_LG + ch]);
                    Y[(size_t)row * DMODEL + 768 + ch] = f2bf(hv * gelu_tanh_f(gt)); } }
        }
    }
}
template <int MODE>
DI void lru_chunk(LAS unsigned char* lds, const Args& a, const LayerP& P, int unit, int wv) {
    const int tid = ltid(wv), c = unit & (NCH - 1), b = unit >> 7, row0 = b * SEQ + c * 128;
    LAS bf16_t* U = (LAS bf16_t*)lds; LAS float* SUM = (LAS float*)(lds + 67584);
    const bf16_t* Hb = (const bf16_t*)(a.ws + WS_H) + (size_t)b * SEQ * HP;
    __syncthreads();
    { const int cv = tid & 31, run = tid >> 5;
#pragma unroll
      for (int hf = 0; hf < 2; ++hf) { const int t0 = run * 8 + hf * 4; float o[4][8]; conv8x4<false>(Hb + C_LX + cv * 8, c * 128 + t0, P.lru_cw + cv * 8, 256, P.lru_cb + cv * 8, o);
#pragma unroll
          for (int t = 0; t < 4; ++t) *(LAS u32x4*)(U + (t0 + t) * PU + cv * 8) = pack8(o[t]); } }
    __syncthreads();
    f32x2* LSWc = (f32x2*)(a.ws + WS_LSW) + (size_t)(b * NCH + c) * 8 * 256;
    if (MODE == 0) {
        lru_sweep<false>(U, SUM, a, P, row0, wv, nullptr, LSWc);
        __syncthreads();
        if (tid < 256) { float Pc = 1.f, Ec = 0.f;
#pragma unroll
            for (int w = 0; w < 8; ++w) { const float Pw = SUM[(w * 256 + tid) * 2], Ew = SUM[(w * 256 + tid) * 2 + 1]; Ec = Pw * Ec + Ew; Pc = Pc * Pw; }
            float* LS = (float*)(a.ws + WS_LSUM) + ((size_t)(b * NCH + c) * 256 + tid) * 2; LS[0] = Pc; LS[1] = Ec; }
    } else {
        lru_sweep<true>(U, SUM, a, P, row0, wv, (const float*)(a.ws + WS_LCARRY) + (size_t)(b * NCH + c) * 256, LSWc);
    }
}

DI void lru_out(const Args& a, int unit, int wv) {
    const int tid = ltid(wv), c = unit & (NCH - 1), b = unit >> 7, row0 = b * SEQ + c * 128, ch = (tid & 63) * 4, k = wv;
    const u32x4* LAI = (const u32x4*)(a.ws + WS_LA); const bf16_t* Hg = (const bf16_t*)(a.ws + WS_H); bf16_t* Y = (bf16_t*)(a.ws + WS_Y);
    const f32x4* LSWc = (const f32x4*)((const f32x2*)(a.ws + WS_LSW) + (size_t)(b * NCH + c) * 8 * 256);
    f32x4 h = *(const f32x4*)((const float*)(a.ws + WS_LCARRY) + (size_t)(b * NCH + c) * 256 + ch);
    f32x4 t0[7], t1[7];
#pragma unroll
    for (int w = 0; w < 7; ++w) if (w < k) { t0[w] = LSWc[(w * 256 + ch) / 2]; t1[w] = LSWc[(w * 256 + ch) / 2 + 1]; }
#pragma unroll
    for (int w = 0; w < 7; ++w) if (w < k) { h[0] = t0[w][0] * h[0] + t0[w][1]; h[1] = t0[w][2] * h[1] + t0[w][3]; h[2] = t1[w][0] * h[2] + t1[w][1]; h[3] = t1[w][2] * h[3] + t1[w][3]; }
    u32x4 pr[16]; u32x2 gt[16];
#pragma unroll
    for (int t = 0; t < 16; ++t) { const size_t row = (size_t)(row0 + 16 * k + t); pr[t] = LAI[(row * 256 + ch) / 4]; gt[t] = *(const u32x2*)(Hg + row * HP + C_LG + ch); }
#pragma unroll
    for (int t = 0; t < 16; ++t) { const unsigned w4[4] = {pr[t].x, pr[t].y, pr[t].z, pr[t].w};
#pragma unroll
        for (int e = 0; e < 4; ++e) { const float oma = __uint_as_float(w4[e] << 16), inp = __uint_as_float(w4[e] & 0xffff0000u); h[e] = (h[e] - oma * h[e]) + inp; }
        const f32x4 g = bf4_to_f32(gt[t]); u32x2 w; w.x = pk2(h[0] * gelu_tanh_f(g[0]), h[1] * gelu_tanh_f(g[1])); w.y = pk2(h[2] * gelu_tanh_f(g[2]), h[3] * gelu_tanh_f(g[3]));
        *(u32x2*)(Y + (size_t)(row0 + 16 * k + t) * DMODEL + 768 + ch) = w; }
}

DI void chunk_scans(const Args& a, int tid) {
    const int gt = lbid() * 512 + tid, NT = lgdim() * 512;
    for (int n = gt; n < 2 * DFF; n += NT) { const float* p1 = (const float*)(a.ws + WS_W + W_PART1) + n; const float* p2 = (const float*)(a.ws + WS_W + W_PART2) + n; float s1 = 0.f, s2 = 0.f;
#pragma unroll
        for (int kb = 0; kb < 16; ++kb) { s1 += p1[(size_t)kb * 2 * DFF]; s2 += p2[(size_t)kb * 2 * DFF]; }
        ((float*)(a.ws + WS_W + W_C1F))[n] = s1; ((float*)(a.ws + WS_W + W_C2F))[n] = s2; }
    for (int idx = gt; idx < 65536 + 32768 + 512; idx += NT) {
        if (idx < 65536) { const int b = idx >> 15, rem = idx & 32767, h = rem >> 13;
            float* p = (float*)((unsigned char*)a.out + DO_ST) + (size_t)b * NCH * 32768 + rem; const float* dec = (const float*)(a.ws + WS_SDEC) + b * NCH * 4 + h; float st = 0.f;
#pragma unroll 1
            for (int c0 = 0; c0 < NCH; c0 += 16) { float t[16], d[16];
#pragma unroll
                for (int j = 0; j < 16; ++j) { t[j] = p[(size_t)(c0 + j) * 32768]; d[j] = dec[(c0 + j) * 4]; }
#pragma unroll
                for (int j = 0; j < 16; ++j) { p[(size_t)(c0 + j) * 32768] = st; st = st * d[j] + t[j]; } }
        } else if (idx < 65536 + 32768) { const int i2 = idx - 65536, b = i2 >> 14, rem = i2 & 16383, h = rem >> 12; const float cd = __expf(ret_lg(h) * 128.0f);
            float* p = (float*)((unsigned char*)a.out + DO_RS) + (size_t)b * NCH * 16384 + rem; float st = 0.f;
#pragma unroll 1
            for (int c0 = 0; c0 < NCH; c0 += 16) { float t[16];
#pragma unroll
                for (int j = 0; j < 16; ++j) t[j] = p[(size_t)(c0 + j) * 16384];
#pragma unroll
                for (int j = 0; j < 16; ++j) { p[(size_t)(c0 + j) * 16384] = st; st = st * cd + t[j]; } }
        } else { const int i3 = idx - 65536 - 32768, b = i3 >> 8, ch = i3 & 255;
            const float* ls = (const float*)(a.ws + WS_LSUM) + ((size_t)b * NCH * 256 + ch) * 2; float* lc = (float*)(a.ws + WS_LCARRY) + (size_t)b * NCH * 256 + ch; float hv = 0.f;
#pragma unroll 1
            for (int c0 = 0; c0 < NCH; c0 += 16) { f32x2 t[16];
#pragma unroll
                for (int j = 0; j < 16; ++j) t[j] = *(const f32x2*)(ls + (c0 + j) * 512);
#pragma unroll
                for (int j = 0; j < 16; ++j) { lc[(c0 + j) * 256] = hv; hv = t[j][0] * hv + t[j][1]; } }
        }
    }
}

#define GSYNC() do { XcdBarrier b_; b_.bar = (unsigned*)(kargs()->ws) + CW_BAR; b_.x = xb_xcc_id(); b_.st = MISC; xcd_barrier(b_, wv0); } while (0)
#ifndef REP_MIX1
#define REP_MIX1 1
#endif
#ifndef REP_MIX2
#define REP_MIX2 1
#endif
#ifndef REP_ATTN
#define REP_ATTN 1
#endif
#ifndef REP_GEMM
#define REP_GEMM 1
#endif
#ifndef REP_LN
#define REP_LN 1
#endif
#ifndef REP_SCAN
#define REP_SCAN 1
#endif
#ifndef REP_F1
#define REP_F1 1
#endif
#ifndef REP_OUT
#define REP_OUT 1
#endif
#ifndef REP_SSD
#define REP_SSD 1
#endif
#ifndef REP_RET
#define REP_RET 1
#endif
#ifndef REP_LRU
#define REP_LRU 1
#endif
#ifndef REP_QKV
#define REP_QKV 1
#endif
#define PH_LOCALS const KArgs ka = kargs(); const Args a = *ka; const int tid = ltid(wv0), lane = tid & 63, wave = __builtin_amdgcn_readfirstlane(tid >> 6), bid = lbid(), G = lgdim(), gw = bid * 8 + wave, NGW = G * 8; (void)lane; (void)gw; (void)NGW; unsigned char* const ws = a.ws; (void)ws; \
    bf16_t* const XB = (bf16_t*)(ws + WS_XB); bf16_t* const Hh = (bf16_t*)(ws + WS_H); bf16_t* const Yb = (bf16_t*)(ws + WS_Y); float* const XF = (float*)(ws + WS_XF); unsigned char* const wb = ws + WS_W; \
    (void)XB; (void)Hh; (void)Yb; (void)XF; (void)wb;
__global__ void __launch_bounds__(512, 2) hybrid_fwd(Args unused_args) {
    extern __shared__ __attribute__((aligned(16))) unsigned char lds_raw[];
    LAS unsigned char* lds = (LAS unsigned char*)lds_raw;
    const int wv0 = __builtin_amdgcn_readfirstlane(threadIdx.x >> 6);
    volatile LAS unsigned* MISC = (volatile LAS unsigned*)(lds + LDS_BYTES - 64);
    if (threadIdx.x < 16) MISC[threadIdx.x] = 0u;
    __syncthreads();
    xcd_barrier_post((unsigned*)(kargs()->ws) + CW_BAR, MISC, wv0);
    cg::grid_group grid = cg::this_grid();

#ifndef REP_P0
#define REP_P0 1
#endif
    for (int rep_ = 0; rep_ < REP_P0; ++rep_)
    { PH_LOCALS
#ifndef SK_CONV
      convert_weights(a, 0, lds, wave, lane);
#endif
      const float* x = a.in[0];
#pragma unroll 4
      for (size_t i = (size_t)bid * 512 + tid; i < (size_t)T * DMODEL / 8; i += (size_t)G * 512) { const f32x4 v0 = ((const f32x4*)x)[2 * i], v1 = ((const f32x4*)x)[2 * i + 1];
          u32x4 w; w.x = pk2(v0[0], v0[1]); w.y = pk2(v0[2], v0[3]); w.z = pk2(v1[0], v1[1]); w.w = pk2(v1[2], v1[3]); ((u32x4*)XB)[i] = w; }
      float* r16 = (float*)(ws + WS_ROPE16); float* r64 = (float*)(ws + WS_ROPE64);
      for (int i = bid * 512 + tid; i < T * 40; i += G * 512) { const int row = i / 40, k = i % 40; const float pos = (float)a.pos[row];
          const float inv = k < 8 ? exp2f(-(float)(2 * k) * (13.287712379549449f / 16.0f)) : exp2f(-(float)(2 * (k - 8)) * (13.287712379549449f / 64.0f));
          const float ang = pos * inv; double ad = (double)ang; ad -= 6.283185307179586 * rint(ad * 0.15915494309189535); const float ar = (float)ad; const float sn = __sinf(ar), cs = __cosf(ar);
          if (k < 8) { r16[(size_t)row * 16 + 2 * k] = cs; r16[(size_t)row * 16 + 2 * k + 1] = sn; } else { r64[(size_t)row * 64 + 2 * (k - 8)] = cs; r64[(size_t)row * 64 + 2 * (k - 8) + 1] = sn; } } }
    if (__builtin_expect(kargs()->ws == nullptr, 0)) grid.sync();
    GSYNC();
#ifdef PROBE_CGSYNC
    for (int i_ = 0; i_ < PROBE_CGSYNC; ++i_) grid.sync();
#endif

    for (int l = 0; l < 2; ++l) {
for (int rep_ = 0; rep_ < REP_GEMM; ++rep_) {
#ifndef SK_G_IN
        { PH_LOCALS
          pg8::Gemm g{XB, (const bf16_t*)(wb + W_IN), T, HP, 1024, 1024}; pg8::StaticOrder S; S.init(T, HP, G, bid);
          EpiIn E{Hh, (float*)(ws + WS_DT), (float*)(ws + WS_SSQQ), (float*)(ws + WS_SSQKV)};
          pg8::gemm_phase<EpiIn, pg8::StaticOrder, true, true>(lds, g, S, E, wv0); }
#endif
}

        GSYNC();
for (int rep_ = 0; rep_ < REP_QKV; ++rep_) {
#ifndef SK_G_KV
        { PH_LOCALS
          pg8::Gemm g{Hh + C_CKV, (const bf16_t*)(wb + W_UKV), T, 512, 256, HP}; pg8::StaticOrder S; S.init(T, 512, G, bid);
          EpiKV E{(bf16_t*)((unsigned char*)a.out + DO_K), (bf16_t*)((unsigned char*)a.out + DO_V), Hh, (const float*)(ws + WS_SSQKV), (const float*)(ws + WS_ROPE16)};
          pg8::gemm_phase<EpiKV, pg8::StaticOrder, true, true>(lds, g, S, E, wv0); }
#endif
}

for (int rep_ = 0; rep_ < REP_MIX1; ++rep_) {
#ifndef SK_SSD1
        { PH_LOCALS const LayerP P = layer_params(ka, l);
          for (int r2_ = 0; r2_ < REP_SSD; ++r2_)
          for (int u = bid; u < NB * NCH; u += G) ssd_pass1(lds, a, P, u, wv0); }
#endif
#ifndef SK_RET1
        { PH_LOCALS
          for (int r2_ = 0; r2_ < REP_RET; ++r2_)
          for (int u = bid; u < NB * NCH; u += G) ret_pass1(lds, a, u, wv0); }
#endif
#ifndef SK_LRU0
        { PH_LOCALS const LayerP P = layer_params(ka, l);
          for (int r2_ = 0; r2_ < REP_LRU; ++r2_)
          for (int u = bid; u < NB * NCH; u += G) lru_chunk<0>(lds, a, P, u, wv0); }
#endif
}

        GSYNC();
#ifdef PROBE_SYNCS
        for (int i_ = 0; i_ < PROBE_SYNCS; ++i_) GSYNC();
#endif
#ifndef SK_SCAN
        { PH_LOCALS chunk_scans(a, tid); }
#endif
for (int rep_ = 0; rep_ < REP_QKV; ++rep_) {
#ifndef SK_G_Q
        { PH_LOCALS
          pg8::Gemm g{Hh + C_CQ, (const bf16_t*)(wb + W_UQ), T, 256, 256, HP}; pg8::StaticOrder S; S.init(T, 256, G, (bid + G / 2) % G);
          EpiQ E{(bf16_t*)((unsigned char*)a.out + DO_Q), (const float*)(ws + WS_SSQQ), (const float*)(ws + WS_ROPE16)};
          pg8::gemm_phase<EpiQ, pg8::StaticOrder, true, true>(lds, g, S, E, wv0); }
#endif
}
        GSYNC();
for (int rep_ = 0; rep_ < REP_MIX2; ++rep_) {
#ifndef SK_SSD2
        { PH_LOCALS const LayerP P = layer_params(ka, l);
          for (int r2_ = 0; r2_ < REP_SSD; ++r2_)
          for (int u = bid; u < NB * NCH; u += G) ssd_pass2(lds, a, P, u, wv0); }
#endif
#ifndef SK_RET2
        { PH_LOCALS const LayerP P = layer_params(ka, l);
          for (int r2_ = 0; r2_ < REP_RET; ++r2_)
          for (int u = bid; u < NB * NCH; u += G) ret_pass2(lds, a, P, u, wv0); }
#endif
#ifndef SK_LRU1
        { PH_LOCALS const LayerP P = layer_params(ka, l);
          for (int r2_ = 0; r2_ < REP_LRU; ++r2_)
          for (int u = bid; u < NB * NCH; u += G) lru_out(a, u, wv0); }
#endif
}

        __syncthreads();
for (int rep_ = 0; rep_ < REP_ATTN; ++rep_) {
#ifndef SK_ATTN
        { PH_LOCALS
          const attn_body::AttnTensors AT{(const attn_body::bf16*)((unsigned char*)a.out + DO_Q), (const attn_body::bf16*)((unsigned char*)a.out + DO_K), (const attn_body::bf16*)((unsigned char*)a.out + DO_V), (attn_body::bf16*)Yb};
          const attn_body::StaticOrder S(G, bid);
          attn_body::attn_phase<attn_body::StaticOrder>((char*)lds_raw, AT, S, wv0); }
#endif
}

        GSYNC();
        for (int rep_ = 0; rep_ < REP_OUT; ++rep_) {
        { PH_LOCALS
          pg8::Gemm g{Yb, (const bf16_t*)(wb + W_OUT), T, 1024, 1024, 1024}; pg8::StaticOrder S; S.init(T, 1024, G, bid);
          EpiResA E{l == 0 ? a.in[0] : (const float*)nullptr, XB, XB, (float*)(ws + WS_STAT1)};
          pg8::gemm_phase<EpiResA, pg8::StaticOrder, true, true>(lds, g, S, E, wv0); }
        }
        GSYNC();
        for (int rep_ = 0; rep_ < REP_F1; ++rep_) {
        { PH_LOCALS
          pg8::Gemm g{XB, (const bf16_t*)(wb + W_F1), T, 2 * DFF, 1024, 1024}; pg8::StaticOrder S; S.init(T, 2 * DFF, G, bid);
          EpiSwiGLU E{Hh, (const float*)(ws + WS_STAT1), (const float*)(wb + W_C1F), (const float*)(wb + W_C2F)};
          pg8::gemm_phase<EpiSwiGLU, pg8::StaticOrder, true, true>(lds, g, S, E, wv0); }
        }
        GSYNC();
        { PH_LOCALS const LayerP P = layer_params(ka, l);
          pg8::Gemm g{Hh, (const bf16_t*)(wb + W_F2), T, 1024, DFF, DFF}; pg8::StaticOrder S; S.init(T, 1024, G, bid);
          EpiResB E{XB, XB, (float*)nullptr, (const float*)(ws + WS_STAT1), P.ln1g, P.ln1b};
          pg8::gemm_phase<EpiResB, pg8::StaticOrder, true, true>(lds, g, S, E, wv0); }
        GSYNC();
        { PH_LOCALS const LayerP P = layer_params(ka, l);
          if (l == 0) { for (int m = gw; m < T; m += 2 * NGW) { const int m2 = m + NGW < T ? m + NGW : m; ln_rows2_bf16(XB + (size_t)m * DMODEL, XB + (size_t)m2 * DMODEL, P.ln2g, P.ln2b, lane, m2 != m); }
                        __syncthreads();
#ifndef SK_CONV
                        convert_weights(a, 1, lds, wave, lane);
#endif
          }
          else { for (int m = gw; m < T; m += 2 * NGW) { const int m2 = m + NGW < T ? m + NGW : m; ln_rows2_bf16_f32(XB + (size_t)m * DMODEL, XB + (size_t)m2 * DMODEL, a.out + (size_t)m * DMODEL, a.out + (size_t)m2 * DMODEL, P.ln2g, P.ln2b, lane, m2 != m); } } }
        if (l == 0) GSYNC();
    }
}

extern "C" void kernel_launch(void* const* d_in, const int* in_sizes, int n_in, void* d_out, int out_size, void* d_ws, size_t ws_size, hipStream_t stream) {
    static int grid = 0;
    if (grid == 0) {
        if (n_in != 29 || in_sizes[0] != T * DMODEL || out_size != T * DMODEL || ws_size < WS_END) { fprintf(stderr, "kernel_launch: unexpected shapes (n_in %d, in0 %d, out %d, ws %zu)\n", n_in, n_in > 0 ? in_sizes[0] : -1, out_size, ws_size); grid = -1; return; }
        int dev = 0, cus = 0, per_cu = 0;
        hipGetDevice(&dev); hipDeviceGetAttribute(&cus, hipDeviceAttributeMultiprocessorCount, dev);
        if (hipFuncSetAttribute((const void*)hybrid_fwd, hipFuncAttributeMaxDynamicSharedMemorySize, LDS_BYTES) != hipSuccess) { fprintf(stderr, "kernel_launch: hipFuncSetAttribute failed\n"); grid = -1; return; }
        if (hipOccupancyMaxActiveBlocksPerMultiprocessor(&per_cu, (const void*)hybrid_fwd, 512, LDS_BYTES) != hipSuccess || per_cu < 1) { fprintf(stderr, "kernel_launch: occupancy query gave %d\n", per_cu); per_cu = 1; }
        (void)hipGetLastError();
        grid = cus * 1;
    }
    if (grid < 0) return;
    Args a{};
    for (int i = 0; i < 29; ++i) a.in[i] = (const float*)d_in[i];
    a.pos = (const int*)d_in[1]; a.out = (float*)d_out; a.ws = (unsigned char*)d_ws;
    if (hipMemsetAsync(d_ws, 0, 65536, stream) != hipSuccess) { fprintf(stderr, "kernel_launch: memset failed\n"); return; }
    void* args[] = {&a};
    hipError_t e = hipLaunchCooperativeKernel((const void*)hybrid_fwd, dim3(grid), dim3(512), args, LDS_BYTES, stream);
    if (e != hipSuccess) fprintf(stderr, "cooperative launch failed: %s (grid %d)\n", hipGetErrorString(e), grid);
}
```

```cpp
#include <hip/hip_runtime.h>
#include <hip/hip_cooperative_groups.h>
#include <cstdio>
#include <cstdint>
__device__ __forceinline__ int ltid(int wv) { int l; asm volatile("v_mbcnt_lo_u32_b32 %0, -1, 0\n\tv_mbcnt_hi_u32_b32 %0, -1, %0" : "=v"(l)); asm volatile("" : "+s"(wv)); return (wv << 6) | l; }
__device__ __forceinline__ int lbid() { int b = blockIdx.x; asm volatile("" : "+s"(b)); return b; }
__device__ __forceinline__ int lgdim() { int g = gridDim.x; asm volatile("" : "+s"(g)); return g; }
namespace pg8 {
#define PG8_LAS __attribute__((address_space(3)))
typedef unsigned short bf16_t;
typedef short bf16x8 __attribute__((ext_vector_type(8)));
typedef float f32x4 __attribute__((ext_vector_type(4)));
typedef unsigned u32x4 __attribute__((ext_vector_type(4)));
constexpr int BM = 256, BK = 64, HALF = 128, HTB = HALF * BK * 2  , STAGE_BYTES = 8 * HTB, NXCD = 8, WGM = 8;

__host__ __device__ __forceinline__ int lds_byte(int r, int c) { const int st = (r >> 4) * 2 + (c >> 5), rr = r & 15, cc = c & 31, ob = rr * 64 + cc * 2; return st * 1024 + (ob ^ (((ob >> 9) & 1) << 5)); }
__host__ __device__ __forceinline__ void stage_rc(int b, int& R, int& C) { const int st = b / 1024, sb = b % 1024, swz = sb ^ (((sb >> 9) & 1) << 5); R = (st >> 1) * 16 + swz / 64; C = (st & 1) * 32 + (swz % 64) / 2; }
__host__ __device__ __forceinline__ int perm32(int rho) { const int n = rho >> 4, i = rho & 15; return 8 * (i >> 2) + 4 * n + (i & 3); }

struct Unit { int pm, pn; };
struct Gemm { const bf16_t* A; const bf16_t* Bt; int M, N, K, lda; };

struct StaticOrder {
    int nM, nN, nwg, G, c;
    __host__ __device__ void init(int M, int N, int G_, int c_) { nM = M / BM; nN = N / BM; nwg = nM * nN; G = G_; c = c_; }
    __host__ __device__ bool next(int i, Unit& u) const {
        const long L = (long)i * G + c; if (L >= nwg) return false;
        int wgid = (int)L; { const int q = nwg / NXCD, r = nwg % NXCD, xcd = wgid % NXCD, off = wgid / NXCD; wgid = (xcd < r ? xcd * (q + 1) : r * (q + 1) + (xcd - r) * q) + off; }
        const int nig = WGM * nN, gid = wgid / nig, fm = gid * WGM, gsz = (nM - fm) < WGM ? (nM - fm) : WGM;
        u.pm = fm + ((wgid % nig) % gsz); u.pn = (wgid % nig) / gsz; return true;
    }
    __device__ __forceinline__ void a_ready(const Unit&) const {}
    __device__ __forceinline__ void done(const Unit&) const {}
};

__device__ __forceinline__ unsigned cvt_pk_bf16(float lo, float hi) { unsigned r; asm volatile("v_cvt_pk_bf16_f32 %0, %1, %2" : "=v"(r) : "v"(lo), "v"(hi)); return r; }
typedef float f32x2 __attribute__((ext_vector_type(2)));
template <class Epi, class Sched, bool ALIGN_EPI = false, bool SP2 = false>
__device__ __forceinline__ void gemm_phase(PG8_LAS unsigned char* lds, const Gemm g, const Sched& S, const Epi& E, int wv) {
    const int tid = ltid(wv), wid = __builtin_amdgcn_readfirstlane(tid >> 6), lane = tid & 63, wr = wid >> 2, wc = wid & 3, fr = lane & 15, fq = lane >> 4;
    const int K = g.K, nt = K / BK;
    unsigned voffA[2], voffB[2];
#pragma unroll
    for (int i = 0; i < 2; ++i) { int R, C; stage_rc(tid * 16 + i * 8192, R, C); const int Rb = Epi::PERM ? ((R & ~31) + perm32(R & 31)) : R;
        voffA[i] = (unsigned)(R * g.lda + C) * 2u; voffB[i] = (unsigned)(Rb * K + C) * 2u; }
    const size_t kstep = (size_t)(BK * 2);
    const size_t hstepA = (size_t)HALF * g.lda * 2, hstepB = (size_t)HALF * K * 2;
    const size_t tstepA = 2 * hstepA, tstepB = 2 * hstepB;
    const unsigned ldsw = (unsigned)wid * 1024u;
    const int aoff = lds_byte(wr * 64 + fr, fq * 8), boff = lds_byte(wc * 32 + fr, fq * 8);
#define PG8_SA(b, h) (((b) * 2 + (h)) * HTB)
#define PG8_SB(b, h) ((4 + (b) * 2 + (h)) * HTB)
#define PG8_STAGE(bufoff, gbase, voff) do { _Pragma("unroll") for (int _i = 0; _i < 2; ++_i) \
        __builtin_amdgcn_global_load_lds((const unsigned*)((const char*)(gbase) + (voff)[_i]), (PG8_LAS unsigned*)(lds + (bufoff) + ldsw + _i * 8192), 16, 0, 0); } while (0)
#define PG8_LDA(dst, b, h) do { _Pragma("unroll") for (int m = 0; m < 4; ++m) _Pragma("unroll") for (int k = 0; k < 2; ++k) dst[m][k] = *(const PG8_LAS bf16x8*)(lds + PG8_SA(b, h) + aoff + m * 2048 + k * 1024); } while (0)
#define PG8_LDB(dst, b, h) do { _Pragma("unroll") for (int n = 0; n < 2; ++n) _Pragma("unroll") for (int k = 0; k < 2; ++k) dst[n][k] = *(const PG8_LAS bf16x8*)(lds + PG8_SB(b, h) + boff + n * 2048 + k * 1024); } while (0)
#define PG8_MMA(ai, bj, At, Bt) do { __builtin_amdgcn_s_setprio(1); _Pragma("unroll") for (int m = 0; m < 4; ++m) _Pragma("unroll") for (int n = 0; n < 2; ++n) _Pragma("unroll") for (int k = 0; k < 2; ++k) \
        acc[ai][bj][m][n] = __builtin_amdgcn_mfma_f32_16x16x32_bf16(Bt[n][k], At[m][k], acc[ai][bj][m][n], 0, 0, 0); __builtin_amdgcn_s_setprio(0); } while (0)
#define PG8_WAIT_V(n) asm volatile("s_waitcnt vmcnt(" #n ")" ::: "memory")
#define PG8_WAIT_L(n) asm volatile("s_waitcnt lgkmcnt(" #n ")" ::: "memory")
#define PG8_BAR __builtin_amdgcn_s_barrier()
#define PG8_SCHED __builtin_amdgcn_sched_barrier(0)
    Unit cur, nxt; int ui = 0;
    if (!S.next(0, cur)) return;
    f32x4 acc[2][2][4][2];
#pragma unroll
    for (int a = 0; a < 2; ++a)
#pragma unroll
        for (int b = 0; b < 2; ++b)
#pragma unroll
            for (int m = 0; m < 4; ++m)
#pragma unroll
                for (int n = 0; n < 2; ++n) acc[a][b][m][n] = (f32x4){0.f, 0.f, 0.f, 0.f};
    bf16x8 At[4][2], B0[2][2], B1[2][2];
    const char* cA = (const char*)g.A + (size_t)cur.pm * tstepA; const char* cB = (const char*)g.Bt + (size_t)cur.pn * tstepB;
    S.a_ready(cur);
    if constexpr (SP2) {
        PG8_STAGE(PG8_SB(0, 0), cB, voffB); PG8_STAGE(PG8_SB(0, 1), cB + hstepB, voffB); PG8_STAGE(PG8_SA(0, 0), cA, voffA); PG8_STAGE(PG8_SA(0, 1), cA + hstepA, voffA);
        if (wr == 1) PG8_BAR;
        PG8_WAIT_V(2); PG8_BAR;
        PG8_STAGE(PG8_SB(1, 0), cB + kstep, voffB); PG8_STAGE(PG8_SA(1, 0), cA + kstep, voffA); PG8_STAGE(PG8_SB(1, 1), cB + hstepB + kstep, voffB);
        PG8_WAIT_V(6); PG8_BAR;
    } else {
        PG8_STAGE(PG8_SB(0, 0), cB, voffB); PG8_STAGE(PG8_SA(0, 0), cA, voffA); PG8_STAGE(PG8_SB(0, 1), cB + hstepB, voffB); PG8_STAGE(PG8_SA(0, 1), cA + hstepA, voffA);
        if (wr == 1) PG8_BAR;
        PG8_WAIT_V(4); PG8_BAR;
        PG8_STAGE(PG8_SB(1, 0), cB + kstep, voffB); PG8_STAGE(PG8_SA(1, 0), cA + kstep, voffA); PG8_STAGE(PG8_SB(1, 1), cB + hstepB + kstep, voffB);
        PG8_WAIT_V(6); PG8_BAR;
    }
    for (;;) {
        const bool has_next = S.next(ui + 1, nxt);
        const char* nA = has_next ? (const char*)g.A + (size_t)nxt.pm * tstepA : cA; const char* nB = has_next ? (const char*)g.Bt + (size_t)nxt.pn * tstepB : cB;
#pragma unroll 1
        for (int t = 0; t < nt; t += 2) {
            const bool last = (t == nt - 2);
            const char* a1 = cA + (size_t)(t + 1) * kstep;
            const char* a2 = last ? nA : cA + (size_t)(t + 2) * kstep; const char* b2 = last ? nB : cB + (size_t)(t + 2) * kstep;
            const char* a3 = a2 + kstep; const char* b3 = b2 + kstep;
            if (last && has_next) S.a_ready(nxt);
            if constexpr (SP2) {
            PG8_LDB(B0, 0, 0); PG8_LDB(B1, 0, 1); PG8_SCHED; PG8_LDA(At, 0, 0); PG8_STAGE(PG8_SA(1, 1), a1 + hstepA, voffA);
            PG8_WAIT_V(8); PG8_WAIT_L(0); PG8_BAR; PG8_MMA(0, 0, At, B0); PG8_MMA(0, 1, At, B1); PG8_BAR; PG8_SCHED;
            PG8_LDA(At, 0, 1); PG8_STAGE(PG8_SB(0, 0), b2, voffB); PG8_STAGE(PG8_SB(0, 1), b2 + hstepB, voffB); PG8_STAGE(PG8_SA(0, 0), a2, voffA);
            PG8_WAIT_V(8); PG8_WAIT_L(0); PG8_BAR; PG8_MMA(1, 0, At, B0); PG8_MMA(1, 1, At, B1); PG8_BAR; PG8_SCHED;
            PG8_LDB(B0, 1, 0); PG8_LDB(B1, 1, 1); PG8_SCHED; PG8_LDA(At, 1, 0); PG8_STAGE(PG8_SA(0, 1), a2 + hstepA, voffA);
            PG8_WAIT_V(8); PG8_WAIT_L(0); PG8_BAR; PG8_MMA(0, 0, At, B0); PG8_MMA(0, 1, At, B1); PG8_BAR; PG8_SCHED;
            PG8_LDA(At, 1, 1); PG8_STAGE(PG8_SB(1, 0), b3, voffB); PG8_STAGE(PG8_SB(1, 1), b3 + hstepB, voffB); PG8_STAGE(PG8_SA(1, 0), a3, voffA);
            PG8_WAIT_V(8); PG8_WAIT_L(0); PG8_BAR; PG8_MMA(1, 0, At, B0); PG8_MMA(1, 1, At, B1); PG8_BAR; PG8_SCHED;
            } else {
            PG8_LDB(B0, 0, 0); PG8_SCHED; PG8_LDA(At, 0, 0); PG8_STAGE(PG8_SA(1, 1), a1 + hstepA, voffA);
            PG8_WAIT_L(8); PG8_BAR; PG8_WAIT_L(0); PG8_MMA(0, 0, At, B0); PG8_BAR; PG8_SCHED;
            PG8_LDB(B1, 0, 1); PG8_STAGE(PG8_SB(0, 0), b2, voffB);
            PG8_BAR; PG8_WAIT_L(0); PG8_MMA(0, 1, At, B1); PG8_BAR;
            PG8_LDA(At, 0, 1); PG8_STAGE(PG8_SA(0, 0), a2, voffA);
            PG8_BAR; PG8_WAIT_L(0); PG8_MMA(1, 0, At, B0); PG8_BAR; PG8_SCHED;
            PG8_STAGE(PG8_SB(0, 1), b2 + hstepB, voffB);
            PG8_WAIT_V(6); PG8_BAR; PG8_MMA(1, 1, At, B1); PG8_BAR;
            PG8_LDB(B0, 1, 0); PG8_SCHED; PG8_LDA(At, 1, 0); PG8_STAGE(PG8_SA(0, 1), a2 + hstepA, voffA);
            PG8_WAIT_L(8); PG8_BAR; PG8_WAIT_L(0); PG8_MMA(0, 0, At, B0); PG8_BAR; PG8_SCHED;
            PG8_LDB(B1, 1, 1); PG8_STAGE(PG8_SB(1, 0), b3, voffB);
            PG8_BAR; PG8_WAIT_L(0); PG8_MMA(0, 1, At, B1); PG8_BAR;
            PG8_LDA(At, 1, 1); PG8_STAGE(PG8_SA(1, 0), a3, voffA);
            PG8_BAR; PG8_WAIT_L(0); PG8_MMA(1, 0, At, B0); PG8_BAR; PG8_SCHED;
            PG8_STAGE(PG8_SB(1, 1), b3 + hstepB, voffB);
            PG8_WAIT_V(6); PG8_BAR; PG8_MMA(1, 1, At, B1); PG8_BAR;
            }
        }
        if constexpr (ALIGN_EPI) { if (wr == 0) PG8_BAR; }
        if constexpr (!Epi::AFTER_DRAIN) { E(acc, cur, wr, wc, fr, fq); S.done(cur); }
        if (!has_next) break;
#pragma unroll
        for (int a = 0; a < 2; ++a)
#pragma unroll
            for (int b = 0; b < 2; ++b)
#pragma unroll
                for (int m = 0; m < 4; ++m)
#pragma unroll
                    for (int n = 0; n < 2; ++n) acc[a][b][m][n] = (f32x4){0.f, 0.f, 0.f, 0.f};
        cur = nxt; cA = nA; cB = nB; ++ui;
        if constexpr (ALIGN_EPI) { if (wr == 1) PG8_BAR; }
    }
    PG8_WAIT_V(0);
    if constexpr (!ALIGN_EPI) { if (wr == 0) PG8_BAR; }
    PG8_BAR;
    if constexpr (Epi::AFTER_DRAIN) { E.fused(acc, cur, wr, wc, fr, fq, lds, wid, lane); S.done(cur); }
#undef PG8_SA
#undef PG8_SB
#undef PG8_STAGE
#undef PG8_LDA
#undef PG8_LDB
#undef PG8_MMA
#undef PG8_WAIT_V
#undef PG8_WAIT_L
#undef PG8_BAR
#undef PG8_SCHED
}
}
#include <hip/hip_bf16.h>
#include <cmath>
namespace attn_body {
using bf16=__hip_bfloat16;
using bf16x8=__attribute__((ext_vector_type(8)))short;
using s16x4=__attribute__((ext_vector_type(4)))short;
using f32x16=__attribute__((ext_vector_type(16)))float;
using u32x4=__attribute__((ext_vector_type(4)))unsigned;
constexpr int BATCH=2,NHEAD=4,SEQ=16384,D=64,DM=NHEAD*D,ODM=1024;
constexpr int NW=8,QBLK=32,QB=QBLK*NW,KVBLK=64,NQB=SEQ/QB;
constexpr int ATTN_PITCH=DM, ATTN_UNIT_ROWS=QB;
__device__ __forceinline__ int crow(int r,int hi){return (r&3)+8*(r>>2)+4*hi;}
#define SBAR() __builtin_amdgcn_sched_barrier(0)
__device__ __forceinline__ void cmask(f32x16&p0,f32x16&p1,int jb,int qrel,int hi){
  const float NEG=-INFINITY; int kb=64*jb+4*hi;
  #pragma unroll
  for(int r=0;r<16;++r){int kv=kb+(r&3)+8*(r>>2); if(kv>qrel)p0[r]=NEG; if(kv+32>qrel)p1[r]=NEG;}
}

constexpr int NSLOT=3, SLOTB=8192;
constexpr int LDS_K=0, LDS_V=NSLOT*SLOTB, LDS_WS=2*NSLOT*SLOTB, LDS_OST=LDS_WS+NW*64*4, LDS_BYTES=LDS_OST+NW*4096;
constexpr float C2=0.125f*1.4426950408889634f;
__device__ __forceinline__ void glds16(const void*gsrc,unsigned lds_dst){unsigned keep;
  asm volatile("s_mov_b32 %0, m0\n\ts_mov_b32 m0, %2\n\ts_nop 0\n\tglobal_load_lds_dwordx4 %1, off\n\ts_mov_b32 m0, %0":"=&s"(keep):"v"(gsrc),"s"(lds_dst):"memory");}
__device__ __forceinline__ float max3f(float a,float b,float c){float r;asm("v_max3_f32 %0, %1, %2, %3":"=v"(r):"v"(a),"v"(b),"v"(c));return r;}
__device__ __forceinline__ float max2f(float a,float b){float r;asm("v_max_f32_e32 %0, %1, %2":"=v"(r):"v"(a),"v"(b));return r;}
__device__ __forceinline__ float fadd_s(float a,float b){float r;asm("v_add_f32_e32 %0, %1, %2":"=v"(r):"v"(a),"v"(b));return r;}
__device__ __forceinline__ float fsub_s(float a,float b){float r;asm("v_sub_f32_e32 %0, %1, %2":"=v"(r):"v"(a),"v"(b));return r;}
typedef float f32x2_t __attribute__((ext_vector_type(2))); typedef __bf16 bf16x2_t __attribute__((ext_vector_type(2)));
__device__ __forceinline__ unsigned cvtpk_s(float lo,float hi){f32x2_t v={lo,hi};bf16x2_t b=__builtin_convertvector(v,bf16x2_t);return __builtin_bit_cast(unsigned,b);}
#define WAIT_BAR(N) asm volatile("s_waitcnt vmcnt(" #N ") lgkmcnt(0)\n\ts_barrier":::"memory")

__device__ __forceinline__ void qkt(f32x16&p0,f32x16&p1,const char*Kslot,const bf16x8*qr,const f32x16&negm,int r32,int hi){
  const char*kb=Kslot+hi*1024+r32*16;
  #pragma unroll
  for(int d0=0;d0<3;++d0){
    const bf16x8 b0=*reinterpret_cast<const bf16x8*>(kb+d0*2048);
    const bf16x8 b1=*reinterpret_cast<const bf16x8*>(kb+d0*2048+512);
    if(d0==0){p0=__builtin_amdgcn_mfma_f32_32x32x16_bf16(b0,qr[0],negm,0,0,0);p1=__builtin_amdgcn_mfma_f32_32x32x16_bf16(b1,qr[0],negm,0,0,0);}
    else{p0=__builtin_amdgcn_mfma_f32_32x32x16_bf16(b0,qr[d0],p0,0,0,0);p1=__builtin_amdgcn_mfma_f32_32x32x16_bf16(b1,qr[d0],p1,0,0,0);}}
}
typedef __attribute__((address_space(3))) const char* lds_cptr;
typedef short v4i16_t __attribute__((ext_vector_type(4)));
__device__ __forceinline__ void kload8(bf16x8*kf,lds_cptr kp){
  kf[0]=*(const __attribute__((address_space(3))) bf16x8*)(kp);      kf[1]=*(const __attribute__((address_space(3))) bf16x8*)(kp+512);
  kf[2]=*(const __attribute__((address_space(3))) bf16x8*)(kp+2048); kf[3]=*(const __attribute__((address_space(3))) bf16x8*)(kp+2560);
  kf[4]=*(const __attribute__((address_space(3))) bf16x8*)(kp+4096); kf[5]=*(const __attribute__((address_space(3))) bf16x8*)(kp+4608);
}
__device__ __forceinline__ void kload2(bf16x8*kf,lds_cptr kp,int j){ kf[2*j]=*(const __attribute__((address_space(3))) bf16x8*)(kp+j*2048); kf[2*j+1]=*(const __attribute__((address_space(3))) bf16x8*)(kp+j*2048+512); }
__device__ __forceinline__ s16x4 vtr(lds_cptr p){ return __builtin_bit_cast(s16x4,__builtin_amdgcn_ds_read_tr16_b64_v4i16((__attribute__((address_space(3))) v4i16_t*)p)); }
__device__ __forceinline__ float rowmax(const f32x16&p0,const f32x16&p1){
  float a=max3f(p0[0],p0[1],p1[0]),b=max3f(p0[2],p0[3],p1[1]);a=max3f(a,p1[2],p1[3]);
  #pragma unroll
  for(int r=4;r<16;r+=4){a=max3f(a,p0[r],p0[r+1]);b=max3f(b,p0[r+2],p0[r+3]);a=max3f(a,p1[r],p1[r+1]);b=max3f(b,p1[r+2],p1[r+3]);}
  const float m=max2f(a,b);
  auto rr=__builtin_amdgcn_permlane32_swap(__float_as_uint(m),__float_as_uint(m),false,false);
  return max2f(__uint_as_float(rr[0]),__uint_as_float(rr[1]));
}
__device__ __forceinline__ void pv(f32x16*o,int vb,bf16x8 pa0,bf16x8 pa1,bf16x8 pa2,bf16x8 pa3){
  #pragma unroll
  for(int d0=0;d0<2;++d0){s16x4 lo[4],hi[4];
    #pragma unroll
    for(int ks=0;ks<4;++ks){
      asm volatile("ds_read_b64_tr_b16 %0,%1 offset:%c2":"=&v"(lo[ks]):"v"(vb),"i"(d0*4096+ks*1024):"memory");
      asm volatile("ds_read_b64_tr_b16 %0,%1 offset:%c2":"=&v"(hi[ks]):"v"(vb),"i"(d0*4096+ks*1024+512):"memory");}
    asm volatile("s_waitcnt lgkmcnt(0)":::"memory");SBAR();
    #define PK(k) (bf16x8){lo[k][0],lo[k][1],lo[k][2],lo[k][3],hi[k][0],hi[k][1],hi[k][2],hi[k][3]}
    o[d0]=__builtin_amdgcn_mfma_f32_32x32x16_bf16(pa0,PK(0),o[d0],0,0,0);
    o[d0]=__builtin_amdgcn_mfma_f32_32x32x16_bf16(pa1,PK(1),o[d0],0,0,0);
    o[d0]=__builtin_amdgcn_mfma_f32_32x32x16_bf16(pa2,PK(2),o[d0],0,0,0);
    o[d0]=__builtin_amdgcn_mfma_f32_32x32x16_bf16(pa3,PK(3),o[d0],0,0,0);
    #undef PK
  }
}

#ifndef ATTN_STORE16
#define ATTN_STORE16(p,v) (*(u32x4*)(p)=(v))
#endif
template<int THRL> __device__ __forceinline__ void attn_unit(int b,int h,int qb,const bf16*Q,const bf16*__restrict__ K,const bf16*__restrict__ V,bf16*O,char*shm,int wv){
  const int tid=ltid(wv),lane=tid&63,r32=lane&31,hi=lane>>5; const int wid=__builtin_amdgcn_readfirstlane(tid>>6);
  const long rowbase=(long)b*SEQ; const int q0=qb*QB;
  const bf16*Qw=Q+(rowbase+q0+wid*QBLK)*DM+h*D;
  const bf16*Kh=K+rowbase*DM+h*D,*Vh=V+rowbase*DM+h*D;
  const unsigned lds0=(unsigned)(uintptr_t)shm;
  float*wsf=(float*)(shm+LDS_WS)+wid*64;
  const bf16*ksrc=Kh+(long)lane*DM+wid*8;
  const bf16*vsrc=Vh+(long)(16*(wid&3)+(lane>>2))*DM+(wid>>2)*32+(lane&3)*8;
  const unsigned kdst=lds0+LDS_K+wid*1024, vdst=lds0+LDS_V+wid*1024;
  #define DMA_K(t,slot) glds16(ksrc+(long)(t)*KVBLK*DM,(unsigned)__builtin_amdgcn_readfirstlane(kdst+(slot)))
  #define DMA_V(t,slot) glds16(vsrc+(long)(t)*KVBLK*DM,(unsigned)__builtin_amdgcn_readfirstlane(vdst+(slot)))
  const int vb0=(int)(lds0+LDS_V)+((lane>>4)&1)*32+(lane&3)*8+(4*hi+((lane&15)>>2))*64;
  const char*Kbase=shm+LDS_K; bf16x8 kf[8];
  const lds_cptr shm3=(lds_cptr)shm; const lds_cptr kp0=shm3+LDS_K+hi*1024+r32*16; const lds_cptr vp0=shm3+LDS_V+((lane>>4)&1)*32+(lane&3)*8+(4*hi+((lane&15)>>2))*64;
  const int NT=(q0+QB)/KVBLK;
  DMA_K(0,0);DMA_V(0,0);DMA_K(1,SLOTB);
  bf16x8 qr[4];
  #pragma unroll
  for(int d0=0;d0<3;++d0)qr[d0]=*reinterpret_cast<const bf16x8*>(&Qw[(long)r32*DM+d0*16+hi*8]);
  float mhat=0.f,l_reg=0.f;f32x16 o[2];o[0]=f32x16{};o[1]=f32x16{};f32x16 negm=f32x16{};asm volatile("":"+v"(negm));
  const int qrel=wid*QBLK+r32;
  #define CMASK(P0,P1,t) do{int jb_=(t)-(NT-4); if(jb_>=0)cmask(P0,P1,jb_,qrel,hi);}while(0)
  bool resc=false;
  #define START(P0,P1) do{ const float rm=rowmax(P0,P1); resc=false; \
    { const float dl=rm; mhat=fadd_s(mhat,dl); \
      _Pragma("unroll") for(int r=0;r<16;++r){P0[r]=fsub_s(P0[r],dl);P1[r]=fsub_s(P1[r],dl);} \
      _Pragma("unroll") for(int r=0;r<16;++r)negm[r]=-mhat; asm volatile("":"+v"(negm)); } \
    _Pragma("unroll") for(int r=0;r<16;++r)P0[r]=__builtin_amdgcn_exp2f(P0[r]); }while(0)
  #define RESC() do{ if(resc){ asm volatile("s_waitcnt lgkmcnt(0)":::"memory"); \
      _Pragma("unroll") for(int d_=0;d_<2;++d_) _Pragma("unroll") for(int r=0;r<16;++r)o[d_][r]*=wsf[crow(r,hi)]; } }while(0)
  f32x16 pA0,pA1,pB0,pB1;
  int sl_prev=0,sl_cur=0,sl_next=SLOTB;
  #define ROT() do{sl_prev=sl_cur;sl_cur=sl_next;sl_next=(sl_next==(NSLOT-1)*SLOTB)?0:sl_next+SLOTB;}while(0)
  DMA_K(2,2*SLOTB);
  WAIT_BAR(3);
  qkt(pA0,pA1,Kbase,qr,negm,r32,hi);asm volatile("s_nop 15\n\ts_nop 7":"+v"(pA0),"+v"(pA1));CMASK(pA0,pA1,0);
  START(pA0,pA1);
  _Pragma("unroll") for(int r=0;r<16;++r)pA1[r]=__builtin_amdgcn_exp2f(pA1[r]);
  WAIT_BAR(0);
  DMA_K(3,0);DMA_V(1,SLOTB);
  ROT();
  kload8(kf,kp0+sl_cur);
  WAIT_BAR(2);
  s16x4 vlo[8],vhi[8]; u32x4 pw0,pw1,pw2,pw3;
  #define PKW(P,B) cvtpk_s(P[B],P[B+1])
  #define PAF(k) __builtin_bit_cast(bf16x8,pw##k)
  #define VFR(i) (bf16x8){vlo[i][0],vlo[i][1],vlo[i][2],vlo[i][3],vhi[i][0],vhi[i][1],vhi[i][2],vhi[i][3]}
  #define PIN(x) asm volatile("":"+v"(x))
  #define MX3(a,b,c) __builtin_fmaxf(__builtin_fmaxf((a),(b)),(c))
  #define GAPA(MF,A0,A1,A2,A3,W0,W1,PW) do{ MF; sacc+=(f32x2_t){A0,A1}; sacc+=(f32x2_t){A2,A3}; PIN(sacc); W0; W1; PIN(PW); SBAR(); }while(0)
  #define EX(v) __builtin_amdgcn_exp2f(v)
  #define GAPB(MF,X,B) do{ MF; X[B]=EX(X[B]); X[B+1]=EX(X[B+1]); X[B+2]=EX(X[B+2]); X[B+3]=EX(X[B+3]); PIN(X); SBAR(); }while(0)
  #define VRD(i) do{ vlo[i]=vtr(vp_+(((i)>>2)*4096+((i)&3)*1024)); vhi[i]=vtr(vp_+(((i)>>2)*4096+((i)&3)*1024+512)); }while(0)
  #define KRD(G,j) do{ if(G){ kload2(kf,kp0+sl_next,j); SBAR(); } }while(0)
  #define STEP(C0,C1,P0,P1,t,GK,GV,GL) do{ SBAR(); \
    const lds_cptr vp_=vp0+sl_prev; \
    VRD(0); SBAR(); f32x2_t sacc=(f32x2_t){P0[0],P0[1]}; \
    GAPA(C0=__builtin_amdgcn_mfma_f32_32x32x16_bf16(kf[0],qr[0],negm,0,0,0), P0[2],P0[3],P0[4],P0[5],     pw0[0]=PKW(P0,0), pw0[1]=PKW(P0,2), pw0); \
    VRD(4); SBAR(); GAPA(C1=__builtin_amdgcn_mfma_f32_32x32x16_bf16(kf[1],qr[0],negm,0,0,0), P0[6],P0[7],P0[8],P0[9],     pw0[2]=PKW(P0,4), pw0[3]=PKW(P0,6), pw0); \
    VRD(1); SBAR(); GAPA(C0=__builtin_amdgcn_mfma_f32_32x32x16_bf16(kf[2],qr[1],C0,0,0,0),   P0[10],P0[11],P0[12],P0[13], pw1[0]=PKW(P0,8), pw1[1]=PKW(P0,10), pw1); \
    VRD(5); SBAR(); GAPA(C1=__builtin_amdgcn_mfma_f32_32x32x16_bf16(kf[3],qr[1],C1,0,0,0),   P0[14],P0[15],P1[0],P1[1],   pw1[2]=PKW(P0,12),pw1[3]=PKW(P0,14), pw1); \
    VRD(2); SBAR(); GAPA(C0=__builtin_amdgcn_mfma_f32_32x32x16_bf16(kf[4],qr[2],C0,0,0,0),   P1[2],P1[3],P1[4],P1[5],     pw2[0]=PKW(P1,0), pw2[1]=PKW(P1,2), pw2); \
    VRD(6); SBAR(); GAPA(C1=__builtin_amdgcn_mfma_f32_32x32x16_bf16(kf[5],qr[2],C1,0,0,0),   P1[6],P1[7],P1[8],P1[9],     pw2[2]=PKW(P1,4), pw2[3]=PKW(P1,6), pw2); \
    VRD(3); SBAR(); GAPA((void)0,   P1[10],P1[11],P1[12],P1[13], pw3[0]=PKW(P1,8), pw3[1]=PKW(P1,10), pw3); \
    VRD(7); SBAR(); GAPA((void)0,   P1[14],P1[15],0.f,0.f,       pw3[2]=PKW(P1,12),pw3[3]=PKW(P1,14), pw3); \
    l_reg+=(sacc.x+sacc.y); \
    if(GK){DMA_K((t)+3,sl_cur);} if(GV){DMA_V((t)+1,sl_next);} \
    CMASK(C0,C1,t); \
    { float a=MX3(C0[0],C0[1],C1[0]),b=MX3(C0[2],C0[3],C1[1]); a=MX3(a,C1[2],C1[3]); \
      _Pragma("unroll") for(int r=4;r<16;r+=4){a=MX3(a,C0[r],C0[r+1]);b=MX3(b,C0[r+2],C0[r+3]);a=MX3(a,C1[r],C1[r+1]);b=MX3(b,C1[r+2],C1[r+3]);} \
      float rm=__builtin_fmaxf(a,b); { auto rr=__builtin_amdgcn_permlane32_swap(__float_as_uint(rm),__float_as_uint(rm),false,false); rm=__builtin_fmaxf(__uint_as_float(rr[0]),__uint_as_float(rr[1])); } \
      resc=false; \
      if(__builtin_expect(__any(rm>(float)THRL),0)){ const float dl=__builtin_fmaxf(rm,0.f); mhat+=dl; \
        _Pragma("unroll") for(int r=0;r<16;++r){C0[r]-=dl;C1[r]-=dl;} \
        _Pragma("unroll") for(int r=0;r<16;++r)negm[r]=-mhat; asm volatile("":"+v"(negm)); \
        const float f=__builtin_amdgcn_exp2f(-dl); l_reg*=f; if(hi==0)wsf[r32]=f; resc=true; } } \
    SBAR(); \
    GAPB(o[0]=__builtin_amdgcn_mfma_f32_32x32x16_bf16(PAF(0),VFR(0),o[0],0,0,0), C0,0); \
    GAPB(o[1]=__builtin_amdgcn_mfma_f32_32x32x16_bf16(PAF(0),VFR(4),o[1],0,0,0), C0,4); \
    KRD(GL,0); GAPB(o[0]=__builtin_amdgcn_mfma_f32_32x32x16_bf16(PAF(1),VFR(1),o[0],0,0,0), C0,8); \
    KRD(GL,1); GAPB(o[1]=__builtin_amdgcn_mfma_f32_32x32x16_bf16(PAF(1),VFR(5),o[1],0,0,0), C0,12); \
    KRD(GL,2); GAPB(o[0]=__builtin_amdgcn_mfma_f32_32x32x16_bf16(PAF(2),VFR(2),o[0],0,0,0), C1,0); \
    GAPB(o[1]=__builtin_amdgcn_mfma_f32_32x32x16_bf16(PAF(2),VFR(6),o[1],0,0,0), C1,4); \
    GAPB(o[0]=__builtin_amdgcn_mfma_f32_32x32x16_bf16(PAF(3),VFR(3),o[0],0,0,0), C1,8); \
    GAPB(o[1]=__builtin_amdgcn_mfma_f32_32x32x16_bf16(PAF(3),VFR(7),o[1],0,0,0), C1,12); \
    }while(0)
  int t=1;
  #undef CMASK
  #define CMASK(P0,P1,t) do{}while(0)
  for(;t+5<NT;t+=2){
    STEP(pB0,pB1,pA0,pA1,t,true,true,true);     WAIT_BAR(2); RESC(); ROT();
    STEP(pA0,pA1,pB0,pB1,t+1,true,true,true);   WAIT_BAR(2); RESC(); ROT();
  }
  #undef CMASK
  #define CMASK(P0,P1,t) do{int jb_=(t)-(NT-4); if(jb_>=0)cmask(P0,P1,jb_,qrel,hi);}while(0)
  #define ENDW(tt) do{ if((tt)+3<NT){WAIT_BAR(2);} else if((tt)+2<NT){WAIT_BAR(1);} else {WAIT_BAR(0);} }while(0)
  for(;t+1<NT;t+=2){
    STEP(pB0,pB1,pA0,pA1,t,(t+3<NT),(t+1<NT),(t+1<NT));       ENDW(t);   RESC(); ROT();
    STEP(pA0,pA1,pB0,pB1,t+1,(t+4<NT),(t+2<NT),(t+2<NT));     ENDW(t+1); RESC(); ROT();
  }
  STEP(pB0,pB1,pA0,pA1,NT-1,false,false,false); RESC();
  { float sacc=pB0[0]+pB0[1]; _Pragma("unroll") for(int r=2;r<16;++r)sacc+=pB0[r]; _Pragma("unroll") for(int r=0;r<16;++r)sacc+=pB1[r]; l_reg+=sacc;
    pw0=(u32x4){PKW(pB0,0),PKW(pB0,2),PKW(pB0,4),PKW(pB0,6)};pw1=(u32x4){PKW(pB0,8),PKW(pB0,10),PKW(pB0,12),PKW(pB0,14)};pw2=(u32x4){PKW(pB1,0),PKW(pB1,2),PKW(pB1,4),PKW(pB1,6)};pw3=(u32x4){PKW(pB1,8),PKW(pB1,10),PKW(pB1,12),PKW(pB1,14)};
    SBAR(); pv(o,vb0+sl_cur,PAF(0),PAF(1),PAF(2),PAF(3)); }
  #undef PKW
  #undef PAF
  #undef VFR
  #undef PIN
  #undef MX3
  #undef GAPA
  #undef GAPB
  #undef EX
  #undef VRD
  #undef KRD
  #undef STEP
  #undef ENDW
  {auto rr=__builtin_amdgcn_permlane32_swap(__float_as_uint(l_reg),__float_as_uint(l_reg),false,false);l_reg=__uint_as_float(rr[0])+__uint_as_float(rr[1]);}
  if(hi==0)wsf[32+r32]=l_reg;asm volatile("s_waitcnt lgkmcnt(0)":::"memory");
  float rli[16];
  #pragma unroll
  for(int r=0;r<16;++r)rli[r]=__builtin_amdgcn_rcpf(wsf[32+crow(r,hi)]);
  bf16*Ow=O+(rowbase+q0+wid*QBLK)*ODM+h*D;
  { bf16*stg=(bf16*)(shm+LDS_OST)+wid*2048;
    #pragma unroll
    for(int r=0;r<16;++r){const int orow=crow(r,hi);
      #pragma unroll
      for(int d0=0;d0<2;++d0)stg[orow*64+d0*32+r32]=__float2bfloat16(o[d0][r]*rli[r]);}
    asm volatile("s_waitcnt lgkmcnt(0)":::"memory");
    #pragma unroll
    for(int i=0;i<4;++i){const int row=i*8+(lane>>3),ch=lane&7; const u32x4 v=*(const u32x4*)(stg+row*64+ch*8); ATTN_STORE16(Ow+(long)row*ODM+ch*8,v);} }
  asm volatile("s_waitcnt lgkmcnt(0)\n\ts_barrier":::"memory");
  #undef DMA_K
  #undef DMA_V
  #undef CMASK
  #undef START
  #undef RESC
  #undef ROT
}
constexpr int ATTN_LDS_BYTES=LDS_BYTES;
struct AttnTensors { const bf16* Q; const bf16* K; const bf16* V; bf16* O; };
struct AttnUnit { int bh; int qb; };
struct StaticOrder {
  int vcu, G;
  __device__ __forceinline__ explicit StaticOrder(int grid,int block):vcu((grid%8==0)?(block%8)*(grid/8)+block/8:block),G(grid){}
  __device__ __forceinline__ bool next(int i,AttnUnit&u)const{ const int pair=vcu+(i>>1)*G; if(pair>=BATCH*NHEAD*(NQB/2))return false; const int s=pair%(NQB/2); u.bh=pair/(NQB/2); u.qb=(i&1)?(NQB-1-s):s; return true; }
  __device__ __forceinline__ void a_ready(const AttnUnit&)const{}
  __device__ __forceinline__ void done(const AttnUnit&)const{}
};
template<class Sched,int THRL=8> __device__ __forceinline__ void attn_phase(char*lds,const AttnTensors&T,const Sched&S,int wv){
  AttnUnit u;
  for(int i=0;S.next(i,u);++i){ S.a_ready(u); attn_unit<THRL>(u.bh/NHEAD,u.bh%NHEAD,u.qb,T.Q,T.K,T.V,T.O,lds,wv); S.done(u); }
}
#undef SBAR
#undef WAIT_BAR
}
namespace cg = cooperative_groups;
#define DI __device__ __forceinline__
#define LAS __attribute__((address_space(3)))
typedef unsigned short bf16_t;
typedef short bf16x8 __attribute__((ext_vector_type(8)));
typedef float f32x4 __attribute__((ext_vector_type(4)));
typedef float f32x2 __attribute__((ext_vector_type(2)));
typedef unsigned u32x4 __attribute__((ext_vector_type(4)));
typedef unsigned u32x2 __attribute__((ext_vector_type(2)));

#define XB_TMO      128
#define XB_XCNT(j)  (256  + 64 * (j))
#define XB_XSUB(j)  (1280 + 64 * (j))
#define XB_XGEN(j)  (2304 + 64 * (j))
#define XB_TOP      3328
#define XB_TOPGEN   3392
#define XCD_BAR_WORDS 3456
#define XB_SPIN_CAP (1u << 18)

__device__ __forceinline__ unsigned xb_ld(unsigned* p)              { return __hip_atomic_load(p, __ATOMIC_RELAXED, __HIP_MEMORY_SCOPE_AGENT); }
__device__ __forceinline__ unsigned xb_add(unsigned* p, unsigned v) { return __hip_atomic_fetch_add(p, v, __ATOMIC_RELAXED, __HIP_MEMORY_SCOPE_AGENT); }
__device__ __forceinline__ unsigned xb_xcc_id() { return (unsigned)__builtin_amdgcn_s_getreg((3 << 11) | 20) & 0xFu; }
#define XB_SPIN(cond, bar) do { unsigned _sp = 0; while (cond) { __builtin_amdgcn_s_sleep(1); \
    if ((++_sp & 255u) == 0u) { if (xb_ld(&(bar)[XB_TMO])) break; if (_sp > XB_SPIN_CAP) { atomicAdd(&(bar)[XB_TMO], 1u); break; } } } } while (0)

struct XcdBarrier {
    unsigned* bar; unsigned x;
    volatile LAS unsigned* st;
};

__device__ __forceinline__ XcdBarrier xcd_barrier_post(unsigned* bar, volatile LAS unsigned* st, int wv) {
    XcdBarrier b; b.bar = bar; b.x = xb_xcc_id(); b.st = st;
    if (ltid(wv) == 0) (void)xb_add(&bar[XB_XCNT(b.x)], 1u);
    return b;
}
__device__ __forceinline__ void xcd_barrier_complete(unsigned* bar, unsigned x, unsigned& nloc, unsigned& nx) {
    const unsigned G = gridDim.x * gridDim.y * gridDim.z;
    unsigned sum, cnt, mine, sp = 0u;
    for (;;) {
        sum = 0u; cnt = 0u; mine = 0u;
#pragma unroll
        for (unsigned j = 0; j < 16; ++j) { const unsigned c = xb_ld(&bar[XB_XCNT(j)]); sum += c; cnt += (c > 0u) ? 1u : 0u; mine = (j == x) ? c : mine; }
        if (sum == G) break;
        __builtin_amdgcn_s_sleep(1);
        if ((++sp & 255u) == 0u) { if (xb_ld(&bar[XB_TMO])) break; if (sp > XB_SPIN_CAP) { atomicAdd(&bar[XB_TMO], 1u); break; } }
    }
    nloc = mine > 0u ? mine : 1u; nx = cnt > 0u ? cnt : 1u;
}

__device__ __forceinline__ void xcd_barrier(const XcdBarrier& b, int wv) {
    asm volatile("s_waitcnt vmcnt(0)" ::: "memory");
    __syncthreads();
    if (ltid(wv) == 0) {
        unsigned* bar = b.bar;
        __builtin_amdgcn_s_waitcnt(0);
        unsigned nloc = b.st[0], nx = b.st[1];
        if (nloc == 0u) { xcd_barrier_complete(bar, b.x, nloc, nx); b.st[0] = nloc; b.st[1] = nx; }
        const unsigned old = xb_add(&bar[XB_XSUB(b.x)], 1u);
        const unsigned gen = old / nloc;
        if (old + 1u == (gen + 1u) * nloc) {
            __builtin_amdgcn_fence(__ATOMIC_RELEASE, "agent");
            asm volatile("s_waitcnt vmcnt(0)" ::: "memory");
            const unsigned og = xb_add(&bar[XB_TOP], 1u);
            const unsigned tg = og / nx;
            if (og + 1u == (tg + 1u) * nx) xb_add(&bar[XB_TOPGEN], 1u);
            else XB_SPIN(xb_ld(&bar[XB_TOPGEN]) == tg, bar);
            __builtin_amdgcn_fence(__ATOMIC_ACQUIRE, "agent");
            xb_add(&bar[XB_XGEN(b.x)], 1u);
            asm volatile("s_waitcnt vmcnt(0)" ::: "memory");
        } else {
            XB_SPIN(xb_ld(&bar[XB_XGEN(b.x)]) == gen, bar);
            __builtin_amdgcn_fence(__ATOMIC_ACQUIRE, "agent");
            asm volatile("s_waitcnt vmcnt(0)" ::: "memory");
        }
    }
    __syncthreads();
}

constexpr int SEQ = 16384, NB = 2, T = NB * SEQ, DMODEL = 1024, NIN = 2964, HP = 3072, DFF = 2816, NCH = SEQ / 128;
constexpr float EPS = 1e-5f, ALPHA = 1.4142135623730951f;
constexpr int C_CQ = 0, C_CKV = 256, C_KR = 384, C_Z = 400, C_XBC = 656, C_RQ = 1424, C_RK = 1680, C_RV = 1936, C_RG = 2192, C_LX = 2448, C_LG = 2704, C_DT = 2960;
constexpr float QSCALE = 0.14433756729740643f * 1.4426950408889634f;

constexpr size_t MiB = 1u << 20;
constexpr size_t WS_W = 1 * MiB;
constexpr size_t W_IN = 0, W_OUT = 6 * MiB, W_F1 = 8 * MiB, W_F2 = 19 * MiB, W_UQ = 24 * MiB + 512 * 1024, W_UKV = W_UQ + 128 * 1024, W_LRU = W_UKV + 256 * 1024;
constexpr size_t WS_ROPE16 = 27 * MiB, WS_ROPE64 = 29 * MiB;
constexpr size_t WS_DT = 37 * MiB, WS_SSQQ = WS_DT + 512 * 1024, WS_SSQKV = WS_SSQQ + 512 * 1024, WS_SDEC = WS_SSQKV + 512 * 1024, WS_LSUM = WS_SDEC + 64 * 1024, WS_LCARRY = WS_LSUM + 512 * 1024;
constexpr size_t WS_XB = 40 * MiB, WS_H = 104 * MiB, WS_Y = 296 * MiB, WS_XF = 360 * MiB, WS_STAT1 = 488 * MiB, WS_END = 492 * MiB;
constexpr size_t WS_YT = WS_XF, WS_LSW = WS_XF + 32 * MiB;
constexpr size_t WS_LA = WS_XF + 40 * MiB, WS_LI = WS_XF + 72 * MiB;
constexpr size_t W_PART1 = 25 * MiB, W_PART2 = W_PART1 + 384 * 1024, W_C1F = W_PART2 + 384 * 1024, W_C2F = W_C1F + 32 * 1024;
constexpr size_t DO_Q = 0, DO_K = 16 * MiB, DO_V = 32 * MiB, DO_ST = 48 * MiB, DO_RS = 80 * MiB;

constexpr int LDS_BYTES = 147456;
constexpr int CW_BAR = 1024;

struct Args {
    const float* in[29];
    const int* pos;
    float* out;
    unsigned char* ws;
};

#if defined(__HIP_DEVICE_COMPILE__)
typedef const __attribute__((address_space(4))) Args* KArgs;
DI KArgs kargs() { KArgs p = (KArgs)__builtin_amdgcn_kernarg_segment_ptr(); asm volatile("" : "+s"(p)); return p; }
#else
typedef const Args* KArgs;
DI KArgs kargs() { return nullptr; }
#endif
DI float bperm(float v, int srclane) { return __int_as_float(__builtin_amdgcn_ds_bpermute(srclane << 2, __float_as_int(v))); }
DI float bf2f(unsigned short u) { return __uint_as_float((unsigned)u << 16); }
typedef __bf16 hwbf16x2 __attribute__((ext_vector_type(2)));
DI unsigned pk2(float lo, float hi) { const f32x2 v = {lo, hi}; const hwbf16x2 b = __builtin_convertvector(v, hwbf16x2); return __builtin_bit_cast(unsigned, b); }
DI unsigned short f2bf(float f) { return (unsigned short)(pk2(f, 0.f) & 0xffffu); }
DI float silu_f(float x) { return x * __builtin_amdgcn_rcpf(1.0f + __expf(-x)); }
DI float sigmoid_f(float x) { return __builtin_amdgcn_rcpf(1.0f + __expf(-x)); }
DI float softplus_f(float x) { return x > 20.f ? x : log1pf(__expf(x)); }
DI float gelu_tanh_f(float x) { const float u = 0.7978845608028654f * (x + 0.044715f * x * x * x); const float th = 1.0f - 2.0f * __builtin_amdgcn_rcpf(1.0f + __expf(2.0f * u)); return 0.5f * x * (1.0f + th); }
DI float one_minus_exp(float x) { const float p = -x * (1.0f + x * (0.5f + x * (0.16666667f + x * (0.041666668f + x * 0.008333334f)))); if (__builtin_expect(__any(x <= -0.5f), 0)) return x > -0.5f ? p : 1.0f - __expf(x); return p; }
DI void unpack8(const u32x4 v, float (&o)[8]) {
    o[0] = __uint_as_float(v.x << 16); o[1] = __uint_as_float(v.x & 0xffff0000u); o[2] = __uint_as_float(v.y << 16); o[3] = __uint_as_float(v.y & 0xffff0000u);
    o[4] = __uint_as_float(v.z << 16); o[5] = __uint_as_float(v.z & 0xffff0000u); o[6] = __uint_as_float(v.w << 16); o[7] = __uint_as_float(v.w & 0xffff0000u);
}
DI u32x4 pack8(const float (&v)[8]) { u32x4 w; w.x = pk2(v[0], v[1]); w.y = pk2(v[2], v[3]); w.z = pk2(v[4], v[5]); w.w = pk2(v[6], v[7]); return w; }

struct EpiIn {
    static constexpr bool PERM = true, AFTER_DRAIN = false;
    bf16_t* H; float* DT; float* SSQQ; float* SSQKV;
    DI void operator()(const f32x4 (&acc)[2][2][4][2], const pg8::Unit& u, int wr, int wc, int fr, int fq) const {
        asm volatile("" : "+v"(fr), "+v"(fq));
        const int row0 = u.pm * 256 + wr * 64 + fr, col0 = u.pn * 256 + wc * 32 + 8 * fq, lane = fq * 16 + fr;
#pragma unroll
        for (int ai = 0; ai < 2; ++ai)
#pragma unroll
            for (int m = 0; m < 4; ++m) {
                const int row = row0 + ai * 128 + m * 16; bf16_t* rowp = H + (size_t)row * HP + col0; float ss[2];
#pragma unroll
                for (int bj = 0; bj < 2; ++bj) { const f32x4 v0 = acc[ai][bj][m][0], v1 = acc[ai][bj][m][1];
                    u32x4 w; w.x = pk2(v0[0], v0[1]); w.y = pk2(v0[2], v0[3]); w.z = pk2(v1[0], v1[1]); w.w = pk2(v1[2], v1[3]);
                    *(u32x4*)(rowp + bj * 128) = w;
                    ss[bj] = (v0[0] * v0[0] + v0[1] * v0[1]) + (v0[2] * v0[2] + v0[3] * v0[3]) + (v1[0] * v1[0] + v1[1] * v1[1]) + (v1[2] * v1[2] + v1[3] * v1[3]); }
                if (u.pn == 0) { float s = ss[0] + ss[1]; s += bperm(s, lane ^ 16); s += bperm(s, lane ^ 32); if (fq == 0) SSQQ[(size_t)row * 4 + wc] = s; }
                else if (u.pn == 1) { float s = ss[0]; s += bperm(s, lane ^ 16); s += bperm(s, lane ^ 32); if (fq == 0) SSQKV[(size_t)row * 4 + wc] = s; }
                else if (u.pn == 11) { if (wc == 0 && fq == 2) *(f32x4*)(DT + (size_t)row * 4) = acc[ai][1][m][0]; }
            }
    }
};
DI void rope4(f32x4& v0, f32x4& v1, const float* tab_row, int fq) {
    const f32x4 cs0 = *(const f32x4*)(tab_row + 8 * fq), cs1 = *(const f32x4*)(tab_row + 8 * fq + 4);
    const float c[4] = {cs0[0], cs0[2], cs1[0], cs1[2]}, s[4] = {cs0[1], cs0[3], cs1[1], cs1[3]};
    f32x4 a, b;
#pragma unroll
    for (int j = 0; j < 4; ++j) { a[j] = v0[j] * c[j] - v1[j] * s[j]; b[j] = v0[j] * s[j] + v1[j] * c[j]; }
    v0 = a; v1 = b;
}
struct EpiQ {
    static constexpr bool PERM = true, AFTER_DRAIN = false;
    bf16_t* Q; const float* SSQ; const float* ROPE16;
    DI void operator()(const f32x4 (&acc)[2][2][4][2], const pg8::Unit& u, int wr, int wc, int fr, int fq) const {
        asm volatile("" : "+v"(fr), "+v"(fq));
        const int row0 = u.pm * 256 + wr * 64 + fr, col0 = wc * 32 + 8 * fq;
#pragma unroll
        for (int ai = 0; ai < 2; ++ai)
#pragma unroll
            for (int m = 0; m < 4; ++m) {
                const int row = row0 + ai * 128 + m * 16; const f32x4 p = *(const f32x4*)(SSQ + (size_t)row * 4);
                const float rs = QSCALE * __builtin_amdgcn_rsqf(((p[0] + p[1]) + (p[2] + p[3])) * (1.0f / 256.0f) + EPS);
#pragma unroll
                for (int bj = 0; bj < 2; ++bj) { f32x4 v0 = acc[ai][bj][m][0] * rs, v1 = acc[ai][bj][m][1] * rs;
                    if ((wc & 1) && fq < 2) rope4(v0, v1, ROPE16 + (size_t)row * 16, fq);
                    u32x4 w; w.x = pk2(v0[0], v0[1]); w.y = pk2(v0[2], v0[3]); w.z = pk2(v1[0], v1[1]); w.w = pk2(v1[2], v1[3]);
                    *(u32x4*)(Q + (size_t)row * 256 + bj * 128 + col0) = w; }
                asm volatile("" ::: "memory");
            }
    }
};
struct EpiKV {
    static constexpr bool PERM = true, AFTER_DRAIN = false;
    bf16_t* Kb; bf16_t* Vb; const bf16_t* H; const float* SSQ; const float* ROPE16;
    DI void operator()(const f32x4 (&acc)[2][2][4][2], const pg8::Unit& u, int wr, int wc, int fr, int fq) const {
        asm volatile("" : "+v"(fr), "+v"(fq));
        const int row0 = u.pm * 256 + wr * 64 + fr, col0 = wc * 32 + 8 * fq;
        bf16_t* dst = u.pn == 0 ? Kb : Vb;
#pragma unroll
        for (int ai = 0; ai < 2; ++ai)
#pragma unroll
            for (int m = 0; m < 4; ++m) {
                const int row = row0 + ai * 128 + m * 16; const f32x4 p = *(const f32x4*)(SSQ + (size_t)row * 4);
                const float rs = __builtin_amdgcn_rsqf(((p[0] + p[1]) + (p[2] + p[3])) * (1.0f / 128.0f) + EPS);
#pragma unroll
                for (int bj = 0; bj < 2; ++bj) { f32x4 v0 = acc[ai][bj][m][0] * rs, v1 = acc[ai][bj][m][1] * rs;
                    if (u.pn == 0 && (wc & 1)) {
                        if (fq < 2) { const u32x2 a = *(const u32x2*)(H + (size_t)row * HP + C_KR + 4 * fq), b = *(const u32x2*)(H + (size_t)row * HP + C_KR + 8 + 4 * fq);
                            v0 = (f32x4){__uint_as_float(a.x << 16), __uint_as_float(a.x & 0xffff0000u), __uint_as_float(a.y << 16), __uint_as_float(a.y & 0xffff0000u)};
                            v1 = (f32x4){__uint_as_float(b.x << 16), __uint_as_float(b.x & 0xffff0000u), __uint_as_float(b.y << 16), __uint_as_float(b.y & 0xffff0000u)};
                            rope4(v0, v1, ROPE16 + (size_t)row * 16, fq); }
                        else { v0 = (f32x4){0.f, 0.f, 0.f, 0.f}; v1 = v0; }
                    }
                    u32x4 w; w.x = pk2(v0[0], v0[1]); w.y = pk2(v0[2], v0[3]); w.z = pk2(v1[0], v1[1]); w.w = pk2(v1[2], v1[3]);
                    *(u32x4*)(dst + (size_t)row * 256 + bj * 128 + col0) = w; }
                asm volatile("" ::: "memory");
            }
    }
};
DI void row_stats(const float* STAT, int row, int fq, int lane, float& mu, float& rstd) {
    const f32x4 a = *(const f32x4*)(STAT + (size_t)row * 32 + fq * 8), b = *(const f32x4*)(STAT + (size_t)row * 32 + fq * 8 + 4);
    float s = (a[0] + a[2]) + (b[0] + b[2]), q = (a[1] + a[3]) + (b[1] + b[3]);
    s += bperm(s, lane ^ 16); q += bperm(q, lane ^ 16); s += bperm(s, lane ^ 32); q += bperm(q, lane ^ 32);
    mu = s * (1.0f / 1024.0f); rstd = __builtin_amdgcn_rsqf(fmaxf(q * (1.0f / 1024.0f) - mu * mu, 0.f) + EPS);
}
DI f32x4 bf4_to_f32(const u32x2 v) { return (f32x4){__uint_as_float(v.x << 16), __uint_as_float(v.x & 0xffff0000u), __uint_as_float(v.y << 16), __uint_as_float(v.y & 0xffff0000u)}; }
struct EpiResA {
    static constexpr bool PERM = true, AFTER_DRAIN = false;
    const float* res32; const bf16_t* res16; bf16_t* XBo; float* STAT;
    DI void operator()(const f32x4 (&acc)[2][2][4][2], const pg8::Unit& u, int wr, int wc, int fr, int fq) const {
        asm volatile("" : "+v"(fr), "+v"(fq));
        const int row0 = u.pm * 256 + wr * 64 + fr, col0 = u.pn * 256 + wc * 32 + 8 * fq, lane = fq * 16 + fr;
#pragma unroll
        for (int ai = 0; ai < 2; ++ai)
#pragma unroll
            for (int m = 0; m < 4; ++m) { const int row = row0 + ai * 128 + m * 16; const size_t off = (size_t)row * DMODEL + col0; float s = 0.f, q = 0.f;
#pragma unroll
                for (int bj = 0; bj < 2; ++bj) { float r[8];
                    if (res32) { const f32x4 r0 = *(const f32x4*)(res32 + off + bj * 128), r1 = *(const f32x4*)(res32 + off + bj * 128 + 4); r[0] = r0[0]; r[1] = r0[1]; r[2] = r0[2]; r[3] = r0[3]; r[4] = r1[0]; r[5] = r1[1]; r[6] = r1[2]; r[7] = r1[3]; }
                    else unpack8(*(const u32x4*)(res16 + off + bj * 128), r);
                    float o[8];
#pragma unroll
                    for (int k = 0; k < 8; ++k) { o[k] = r[k] * ALPHA + acc[ai][bj][m][k >> 2][k & 3]; s += o[k]; q += o[k] * o[k]; }
                    *(u32x4*)(XBo + off + bj * 128) = pack8(o); }
                s += bperm(s, lane ^ 16); q += bperm(q, lane ^ 16); s += bperm(s, lane ^ 32); q += bperm(q, lane ^ 32);
                if (fq == 0) *(f32x2*)(STAT + (size_t)row * 32 + (u.pn * 4 + wc) * 2) = (f32x2){s, q};
                if (m == 3) asm volatile("" ::: "memory"); }
    }
};
struct EpiResB {
    static constexpr bool PERM = true, AFTER_DRAIN = false;
    const bf16_t* XBin; bf16_t* XBout; float* out32; const float* STAT; const float* g; const float* b;
    DI void operator()(const f32x4 (&acc)[2][2][4][2], const pg8::Unit& u, int wr, int wc, int fr, int fq) const {
        asm volatile("" : "+v"(fr), "+v"(fq));
        const int row0 = u.pm * 256 + wr * 64 + fr, col0 = u.pn * 256 + wc * 32 + 8 * fq, lane = fq * 16 + fr;
#pragma unroll
        for (int ai = 0; ai < 2; ++ai)
#pragma unroll
            for (int m = 0; m < 4; ++m) { const int row = row0 + ai * 128 + m * 16; const size_t off = (size_t)row * DMODEL + col0; float mu, rstd; row_stats(STAT, row, fq, lane, mu, rstd);
#pragma unroll
                for (int bj = 0; bj < 2; ++bj) { float p[8]; unpack8(*(const u32x4*)(XBin + off + bj * 128), p);
                    const f32x4 g0 = *(const f32x4*)(g + col0 + bj * 128), g1 = *(const f32x4*)(g + col0 + bj * 128 + 4), b0 = *(const f32x4*)(b + col0 + bj * 128), b1 = *(const f32x4*)(b + col0 + bj * 128 + 4);
                    float o[8];
#pragma unroll
                    for (int k = 0; k < 8; ++k) { const float gg = k < 4 ? g0[k & 3] : g1[k & 3], bb = k < 4 ? b0[k & 3] : b1[k & 3]; const float x1 = (p[k] - mu) * rstd * gg + bb; o[k] = x1 * ALPHA + acc[ai][bj][m][k >> 2][k & 3]; }
                    if (out32) { *(f32x4*)(out32 + off + bj * 128) = (f32x4){o[0], o[1], o[2], o[3]}; *(f32x4*)(out32 + off + bj * 128 + 4) = (f32x4){o[4], o[5], o[6], o[7]}; }
                    else *(u32x4*)(XBout + off + bj * 128) = pack8(o); }
                if (m == 3) asm volatile("" ::: "memory"); }
    }
};
struct EpiSwiGLU {
    static constexpr bool PERM = true, AFTER_DRAIN = false;
    bf16_t* HID; const float* STAT; const float* C1; const float* C2;
    DI void operator()(const f32x4 (&acc)[2][2][4][2], const pg8::Unit& u, int wr, int wc, int fr, int fq) const {
        asm volatile("" : "+v"(fr), "+v"(fq));
        const int row0 = u.pm * 256 + wr * 64 + fr, col0 = u.pn * 128 + wc * 32 + 8 * fq, lane = fq * 16 + fr, cc = u.pn * 256 + wc * 32 + 8 * fq;
        f32x4 c1[2][2], c2[2][2];
#pragma unroll
        for (int bj = 0; bj < 2; ++bj)
#pragma unroll
            for (int n = 0; n < 2; ++n) { c1[bj][n] = *(const f32x4*)(C1 + cc + bj * 128 + n * 4); c2[bj][n] = *(const f32x4*)(C2 + cc + bj * 128 + n * 4); }
#pragma unroll
        for (int ai = 0; ai < 2; ++ai)
#pragma unroll
            for (int m = 0; m < 4; ++m) { const int row = row0 + ai * 128 + m * 16; float mu, rstd; row_stats(STAT, row, fq, lane, mu, rstd);
                const f32x4 g0 = (acc[ai][0][m][0] - c1[0][0] * mu) * rstd + c2[0][0], g1 = (acc[ai][0][m][1] - c1[0][1] * mu) * rstd + c2[0][1];
                const f32x4 u0 = (acc[ai][1][m][0] - c1[1][0] * mu) * rstd + c2[1][0], u1 = (acc[ai][1][m][1] - c1[1][1] * mu) * rstd + c2[1][1];
                u32x4 w; w.x = pk2(silu_f(g0[0]) * u0[0], silu_f(g0[1]) * u0[1]); w.y = pk2(silu_f(g0[2]) * u0[2], silu_f(g0[3]) * u0[3]);
                w.z = pk2(silu_f(g1[0]) * u1[0], silu_f(g1[1]) * u1[1]); w.w = pk2(silu_f(g1[2]) * u1[2], silu_f(g1[3]) * u1[3]);
                *(u32x4*)(HID + (size_t)row * DFF + col0) = w; }
    }
};

DI float wave_sum(float v, int lane) {
#pragma unroll
    for (int o = 1; o < 64; o <<= 1) v += bperm(v, lane ^ o);
    return v;
}
template <int MI, int NI>
DI void wgemm(f32x4 (&acc)[MI][NI], const LAS bf16_t* A, int pa, const LAS bf16_t* Bt, int pb, int K, int lane) {
    const int r = lane & 15, q = lane >> 4;
    const LAS bf16_t* ap = A + r * pa + q * 8; const LAS bf16_t* bp = Bt + r * pb + q * 8;
#pragma unroll 1
    for (int k = 0; k < K; k += 32) {
        bf16x8 a[MI], b[NI];
#pragma unroll
        for (int mi = 0; mi < MI; ++mi) a[mi] = *(const LAS bf16x8*)(ap + mi * 16 * pa + k);
#pragma unroll
        for (int ni = 0; ni < NI; ++ni) b[ni] = *(const LAS bf16x8*)(bp + ni * 16 * pb + k);
#pragma unroll
        for (int mi = 0; mi < MI; ++mi)
#pragma unroll
            for (int ni = 0; ni < NI; ++ni) acc[mi][ni] = __builtin_amdgcn_mfma_f32_16x16x32_bf16(a[mi], b[ni], acc[mi][ni], 0, 0, 0);
    }
}
template <int MI, int NI> DI void zero_acc(f32x4 (&acc)[MI][NI]) {
#pragma unroll
    for (int mi = 0; mi < MI; ++mi)
#pragma unroll
        for (int ni = 0; ni < NI; ++ni) acc[mi][ni] = (f32x4){0.f, 0.f, 0.f, 0.f};
}
DI void conv_load(const bf16_t* src, int s0, u32x4 (&raw)[7]) {
#pragma unroll
    for (int i = 0; i < 7; ++i) { const int s = s0 - 3 + i; raw[i] = (s >= 0) ? *(const u32x4*)(src + (size_t)s * HP) : (u32x4){0u, 0u, 0u, 0u}; }
}
template <bool SILU>
DI void conv_compute(const u32x4 (&raw)[7], const float* w, int C, const float* bias, float (&out)[4][8]) {
    float wv[4][8], bv[8], x[7][8];
#pragma unroll
    for (int j = 0; j < 4; ++j) { const f32x4 a = *(const f32x4*)(w + (size_t)j * C), b = *(const f32x4*)(w + (size_t)j * C + 4);
        wv[j][0] = a[0]; wv[j][1] = a[1]; wv[j][2] = a[2]; wv[j][3] = a[3]; wv[j][4] = b[0]; wv[j][5] = b[1]; wv[j][6] = b[2]; wv[j][7] = b[3]; }
    { const f32x4 a = *(const f32x4*)bias, b = *(const f32x4*)(bias + 4); bv[0] = a[0]; bv[1] = a[1]; bv[2] = a[2]; bv[3] = a[3]; bv[4] = b[0]; bv[5] = b[1]; bv[6] = b[2]; bv[7] = b[3]; }
#pragma unroll
    for (int i = 0; i < 7; ++i) unpack8(raw[i], x[i]);
#pragma unroll
    for (int t = 0; t < 4; ++t)
#pragma unroll
        for (int c = 0; c < 8; ++c) { float v = bv[c] + wv[0][c] * x[t][c] + wv[1][c] * x[t + 1][c] + wv[2][c] * x[t + 2][c] + wv[3][c] * x[t + 3][c]; out[t][c] = SILU ? silu_f(v) : v; }
}
template <bool SILU>
DI void conv8x4(const bf16_t* src, int s0, const float* w, int C, const float* bias, float (&out)[4][8]) { u32x4 raw[7]; conv_load(src, s0, raw); conv_compute<SILU>(raw, w, C, bias, out); }

struct LayerP {
    const float *g_q, *w_uq, *g_kv, *w_ukv, *ssd_cw, *ssd_cb, *ssd_dtb, *ssd_alog, *ssd_d, *ssd_ng, *ret_g, *ret_b, *lru_cw, *lru_cb, *lru_wa, *lru_ba, *lru_wx, *lru_bx, *lru_ap, *ln1g, *ln1b, *ln2g, *ln2b;
    const float *w_in, *w_out, *w_f1, *w_f2;
};
DI LayerP layer_params(KArgs ka, int l) {
    const Args a = *ka;
    LayerP p;
    p.w_in = a.in[2] + (size_t)l * DMODEL * NIN; p.g_q = a.in[3] + l * 256; p.w_uq = a.in[4] + (size_t)l * 256 * 192; p.g_kv = a.in[5] + l * 128; p.w_ukv = a.in[6] + (size_t)l * 128 * 384;
    p.ssd_cw = a.in[7] + l * 4 * 768; p.ssd_cb = a.in[8] + l * 768; p.ssd_dtb = a.in[9] + l * 4; p.ssd_alog = a.in[10] + l * 4; p.ssd_d = a.in[11] + l * 4; p.ssd_ng = a.in[12] + l * 256;
    p.ret_g = a.in[13] + l * 256; p.ret_b = a.in[14] + l * 256; p.lru_cw = a.in[15] + l * 4 * 256; p.lru_cb = a.in[16] + l * 256; p.lru_wa = a.in[17] + l * 16384; p.lru_ba = a.in[18] + l * 256;
    p.lru_wx = a.in[19] + l * 16384; p.lru_bx = a.in[20] + l * 256; p.lru_ap = a.in[21] + l * 256; p.w_out = a.in[22] + (size_t)l * 1024 * 1024; p.ln1g = a.in[23] + l * 1024; p.ln1b = a.in[24] + l * 1024;
    p.w_f1 = a.in[25] + (size_t)l * 1024 * 2 * DFF; p.w_f2 = a.in[26] + (size_t)l * DFF * 1024; p.ln2g = a.in[27] + l * 1024; p.ln2b = a.in[28] + l * 1024;
    return p;
}

template <class SrcCol>
DI void transpose_w(const float* W, int K, int Nsrc, bf16_t* WT, int Ndst, const float* gain, SrcCol sc, LAS float* scr, int gw, int NGW, int lane, int Kvalid = 1 << 30, const float* bias = nullptr, float* PART1 = nullptr, float* PART2 = nullptr) {
    const int nblk = Ndst / 32, nitems = (K / 64) * nblk;
    for (int it = gw; it < nitems; it += NGW) {
        const int kb = it / nblk, nb = it % nblk, k0 = 64 * kb, n0 = 32 * nb;
        const int src = sc(n0 + (lane & 31));
        float a1 = 0.f, a2 = 0.f;
#pragma unroll
        for (int i = 0; i < 32; ++i) { const int kk = 2 * i + (lane >> 5); float v = 0.f; if (src >= 0 && k0 + kk < Kvalid) { const float w = W[(size_t)(k0 + kk) * Nsrc + src]; v = gain ? w * gain[k0 + kk] : w; if (PART1) { a1 += bf2f(f2bf(v)); a2 += bias[k0 + kk] * w; } } scr[kk * 33 + (lane & 31)] = v; }
        if (PART1) { a1 += bperm(a1, lane ^ 32); a2 += bperm(a2, lane ^ 32); if (lane < 32) { PART1[(size_t)kb * Ndst + n0 + lane] = a1; PART2[(size_t)kb * Ndst + n0 + lane] = a2; } }
        asm volatile("s_waitcnt lgkmcnt(0)" ::: "memory");
        const int c = lane & 7;
#pragma unroll
        for (int j = 0; j < 4; ++j) { const int n = (lane >> 3) + 8 * j; const LAS float* s = scr + (8 * c) * 33 + n;
            u32x4 o; o.x = pk2(s[0 * 33], s[1 * 33]); o.y = pk2(s[2 * 33], s[3 * 33]); o.z = pk2(s[4 * 33], s[5 * 33]); o.w = pk2(s[6 * 33], s[7 * 33]);
            *(u32x4*)(WT + (size_t)(n0 + n) * K + k0 + 8 * c) = o; }
        asm volatile("s_waitcnt lgkmcnt(0)" ::: "memory");
    }
}
struct ScIn { DI int operator()(int n) const { return n < 1424 ? n : (n < 2960 ? n + 4 : (n < 2964 ? 1424 + (n - 2960) : -1)); } };
struct ScId { DI int operator()(int n) const { return n; } };
struct ScUq { DI int operator()(int n) const { const int h = n >> 6, e = n & 63; if (e < 32) return h * 48 + e; if (e >= 48) return -1; const int j = e - 32, fq = j >> 3, s = j & 7; return h * 48 + 32 + (s < 4 ? 4 * fq + s : 4 * fq + s + 4); } };
struct ScUkv { DI int operator()(int n) const { const int h = (n & 255) >> 6, e = n & 63; if (n < 256) return e < 32 ? h * 96 + e : -1; return h * 96 + 32 + e; } };
struct ScF1 { DI int operator()(int n) const { const int pn = n >> 8, x = n & 127; return (n & 128) ? DFF + 128 * pn + x : 128 * pn + x; } };

DI void convert_weights(const Args& a, int l, LAS unsigned char* lds, int wave, int lane) {
    const LayerP P = layer_params(kargs(), l);
    unsigned char* wb = a.ws + WS_W;
    LAS float* scr = (LAS float*)(lds + wave * 16384);
    const int gw0 = lbid() * 8 + wave, NGW = lgdim() * 8; int gw = gw0, base = 0;
#define NEXT_MAT(K_, N_) do { base = (base + ((K_) / 64) * ((N_) / 32)) % NGW; gw = gw0 - base; if (gw < 0) gw += NGW; } while (0)
    transpose_w(P.w_f1, 1024, 2 * DFF, (bf16_t*)(wb + W_F1), 2 * DFF, P.ln1g, ScF1(), scr, gw, NGW, lane, 1 << 30, P.ln1b, (float*)(wb + W_PART1), (float*)(wb + W_PART2));
    NEXT_MAT(1024, 2 * DFF);
    transpose_w(P.w_in, 1024, NIN, (bf16_t*)(wb + W_IN), HP, nullptr, ScIn(), scr, gw, NGW, lane);
    NEXT_MAT(1024, HP);
    transpose_w(P.w_f2, DFF, 1024, (bf16_t*)(wb + W_F2), 1024, nullptr, ScId(), scr, gw, NGW, lane);
    NEXT_MAT(DFF, 1024);
    transpose_w(P.w_out, 1024, 1024, (bf16_t*)(wb + W_OUT), 1024, nullptr, ScId(), scr, gw, NGW, lane);
    NEXT_MAT(1024, 1024);
    transpose_w(P.w_uq, 256, 192, (bf16_t*)(wb + W_UQ), 256, P.g_q, ScUq(), scr, gw, NGW, lane);
    NEXT_MAT(256, 256);
    transpose_w(P.w_ukv, 256, 384, (bf16_t*)(wb + W_UKV), 512, P.g_kv, ScUkv(), scr, gw, NGW, lane, 128);
    NEXT_MAT(256, 512);
    for (int m = 0; m < 8; ++m)
        { transpose_w((m < 4 ? P.lru_wa : P.lru_wx) + (m & 3) * 4096, 64, 64, (bf16_t*)(wb + W_LRU) + m * 4096, 64, nullptr, ScId(), scr, gw, NGW, lane); NEXT_MAT(64, 64); }
#undef NEXT_MAT
}

DI void ln_row(const float* xrow, const float* g, const float* b, float* orow, bf16_t* obf, int lane) {
    const f32x4* xr = (const f32x4*)xrow + lane;
    f32x4 v[4]; float s = 0.f;
#pragma unroll
    for (int j = 0; j < 4; ++j) { v[j] = xr[64 * j]; s += (v[j][0] + v[j][1]) + (v[j][2] + v[j][3]); }
    const float mean = wave_sum(s, lane) * (1.f / 1024.f); float s2 = 0.f;
#pragma unroll
    for (int j = 0; j < 4; ++j) { v[j] = v[j] - mean; s2 += (v[j][0] * v[j][0] + v[j][1] * v[j][1]) + (v[j][2] * v[j][2] + v[j][3] * v[j][3]); }
    const float rstd = 1.f / sqrtf(wave_sum(s2, lane) * (1.f / 1024.f) + EPS);
#pragma unroll
    for (int j = 0; j < 4; ++j) { const f32x4 gg = ((const f32x4*)g)[lane + 64 * j], bb = ((const f32x4*)b)[lane + 64 * j]; const f32x4 o = v[j] * rstd * gg + bb;
        ((f32x4*)orow)[lane + 64 * j] = o;
        if (obf) { u32x2 w; w.x = pk2(o[0], o[1]); w.y = pk2(o[2], o[3]); ((u32x2*)obf)[lane + 64 * j] = w; } }
}

DI void ln_rows2_bf16(bf16_t* xa, bf16_t* xb, const float* g, const float* b, int lane, bool two) {
    u32x4* xr[2] = {(u32x4*)xa, (u32x4*)xb}; float v[2][2][8]; float s[2] = {0.f, 0.f}, s2[2] = {0.f, 0.f}, mean[2], rstd[2];
    u32x4 raw[2][2];
#pragma unroll
    for (int r = 0; r < 2; ++r)
#pragma unroll
        for (int j = 0; j < 2; ++j) raw[r][j] = xr[r][lane + 64 * j];
#pragma unroll
    for (int r = 0; r < 2; ++r)
#pragma unroll
        for (int j = 0; j < 2; ++j) { unpack8(raw[r][j], v[r][j]);
#pragma unroll
            for (int k = 0; k < 8; ++k) s[r] += v[r][j][k]; }
#pragma unroll
    for (int o = 1; o < 64; o <<= 1) { s[0] += bperm(s[0], lane ^ o); s[1] += bperm(s[1], lane ^ o); }
#pragma unroll
    for (int r = 0; r < 2; ++r) { mean[r] = s[r] * (1.f / 1024.f);
#pragma unroll
        for (int j = 0; j < 2; ++j)
#pragma unroll
            for (int k = 0; k < 8; ++k) { v[r][j][k] -= mean[r]; s2[r] += v[r][j][k] * v[r][j][k]; } }
#pragma unroll
    for (int o = 1; o < 64; o <<= 1) { s2[0] += bperm(s2[0], lane ^ o); s2[1] += bperm(s2[1], lane ^ o); }
#pragma unroll
    for (int r = 0; r < 2; ++r) rstd[r] = 1.f / sqrtf(s2[r] * (1.f / 1024.f) + EPS);
#pragma unroll
    for (int j = 0; j < 2; ++j) { const int c0 = (lane + 64 * j) * 8; const f32x4 g0 = *(const f32x4*)(g + c0), g1 = *(const f32x4*)(g + c0 + 4), b0 = *(const f32x4*)(b + c0), b1 = *(const f32x4*)(b + c0 + 4);
#pragma unroll
        for (int r = 0; r < 2; ++r) { float o[8];
#pragma unroll
            for (int k = 0; k < 4; ++k) { o[k] = v[r][j][k] * rstd[r] * g0[k] + b0[k]; o[4 + k] = v[r][j][4 + k] * rstd[r] * g1[k] + b1[k]; }
            if (r == 0 || two) xr[r][lane + 64 * j] = pack8(o); } }
}
DI void ln_rows2_f32(float* xa, float* xb, const float* g, const float* b, int lane, bool two) {
    f32x4* xr[2] = {(f32x4*)xa, (f32x4*)xb}; f32x4 v[2][4]; float s[2] = {0.f, 0.f}, s2[2] = {0.f, 0.f}, mean[2], rstd[2];
#pragma unroll
    for (int r = 0; r < 2; ++r)
#pragma unroll
        for (int j = 0; j < 4; ++j) v[r][j] = xr[r][lane + 64 * j];
#pragma unroll
    for (int r = 0; r < 2; ++r)
#pragma unroll
        for (int j = 0; j < 4; ++j) s[r] += (v[r][j][0] + v[r][j][1]) + (v[r][j][2] + v[r][j][3]);
#pragma unroll
    for (int o = 1; o < 64; o <<= 1) { s[0] += bperm(s[0], lane ^ o); s[1] += bperm(s[1], lane ^ o); }
#pragma unroll
    for (int r = 0; r < 2; ++r) { mean[r] = s[r] * (1.f / 1024.f);
#pragma unroll
        for (int j = 0; j < 4; ++j) { v[r][j] = v[r][j] - mean[r]; s2[r] += (v[r][j][0] * v[r][j][0] + v[r][j][1] * v[r][j][1]) + (v[r][j][2] * v[r][j][2] + v[r][j][3] * v[r][j][3]); } }
#pragma unroll
    for (int o = 1; o < 64; o <<= 1) { s2[0] += bperm(s2[0], lane ^ o); s2[1] += bperm(s2[1], lane ^ o); }
#pragma unroll
    for (int r = 0; r < 2; ++r) rstd[r] = 1.f / sqrtf(s2[r] * (1.f / 1024.f) + EPS);
#pragma unroll
    for (int j = 0; j < 4; ++j) { const f32x4 gg = ((const f32x4*)g)[lane + 64 * j], bb = ((const f32x4*)b)[lane + 64 * j];
#pragma unroll
        for (int r = 0; r < 2; ++r) if (r == 0 || two) xr[r][lane + 64 * j] = v[r][j] * rstd[r] * gg + bb; }
}

constexpr int PT = 136;
DI void ssd_acs(const float* DT, const LayerP& P, int row0, int h, LAS float* acs, LAS float* dtl, int lane) {
    const float bias = P.ssd_dtb[h], A = -__expf(P.ssd_alog[h]);
    const float d0 = softplus_f(DT[(size_t)(row0 + 2 * lane) * 4 + h] + bias), d1 = softplus_f(DT[(size_t)(row0 + 2 * lane + 1) * 4 + h] + bias);
    const float a0 = d0 * A, a1 = d1 * A; float incl = a0 + a1;
#pragma unroll
    for (int o = 1; o < 64; o <<= 1) { const float t = bperm(incl, lane - o); if (lane >= o) incl += t; }
    const float excl = incl - (a0 + a1);
    acs[2 * lane] = excl + a0; acs[2 * lane + 1] = incl; dtl[2 * lane] = d0; dtl[2 * lane + 1] = d1;
}
DI void ssd_pass1(LAS unsigned char* lds, const Args& a, const LayerP& P, int unit, int wv) {
    const int tid = ltid(wv), lane = tid & 63, wave = wv;
    const int c = unit & (NCH - 1), b = unit >> 7, row0 = b * SEQ + c * 128;
    const bf16_t* Hb = (const bf16_t*)(a.ws + WS_H) + (size_t)b * SEQ * HP;
    LAS bf16_t* BT = (LAS bf16_t*)lds; LAS bf16_t* XT = (LAS bf16_t*)(lds + 69632); LAS float* acs = (LAS float*)(lds + 139264); LAS float* dtl = (LAS float*)(lds + 141312);
    const int cv = tid & 15, t0 = (tid >> 4) * 4;
    u32x4 rawX[2][7], rawB[2][7];
#pragma unroll
    for (int g = 0; g < 2; ++g) { conv_load(Hb + C_XBC + g * 128 + cv * 8, c * 128 + t0, rawX[g]); conv_load(Hb + C_XBC + 256 + g * 128 + cv * 8, c * 128 + t0, rawB[g]); }
    __syncthreads();
    if (wave < 4) ssd_acs((const float*)(a.ws + WS_DT), P, row0, wave, acs + wave * 128, dtl + wave * 128, lane);
    __syncthreads();
#pragma unroll
    for (int g = 0; g < 2; ++g) {
        { float o[4][8]; conv_compute<true>(rawX[g], P.ssd_cw + g * 128 + cv * 8, 768, P.ssd_cb + g * 128 + cv * 8, o);
          const int h = 2 * g + (cv >> 3); const float ae = acs[h * 128 + 127]; float w[4];
#pragma unroll
          for (int t = 0; t < 4; ++t) w[t] = __expf(ae - acs[h * 128 + t0 + t]) * dtl[h * 128 + t0 + t];
#pragma unroll
          for (int k = 0; k < 8; ++k) { u32x2 v; v.x = pk2(o[0][k] * w[0], o[1][k] * w[1]); v.y = pk2(o[2][k] * w[2], o[3][k] * w[3]); *(LAS u32x2*)(XT + (h * 64 + (cv & 7) * 8 + k) * PT + t0) = v; } }
        { float o[4][8]; conv_compute<true>(rawB[g], P.ssd_cw + 256 + g * 128 + cv * 8, 768, P.ssd_cb + 256 + g * 128 + cv * 8, o);
#pragma unroll
          for (int k = 0; k < 8; ++k) { u32x2 v; v.x = pk2(o[0][k], o[1][k]); v.y = pk2(o[2][k], o[3][k]); *(LAS u32x2*)(BT + (g * 128 + cv * 8 + k) * PT + t0) = v; } }
    }
    __syncthreads();
    const int h = wave >> 1, nb = (wave & 1) * 64, r = lane & 15, q = lane >> 4;
    f32x4 acc[4][4]; zero_acc(acc);
    wgemm<4, 4>(acc, BT + ((h >> 1) * 128 + nb) * PT, PT, XT + h * 64 * PT, PT, 128, lane);
    float* ST = (float*)((unsigned char*)a.out + DO_ST) + ((size_t)((b * NCH + c) * 4 + h)) * 8192;
#pragma unroll
    for (int mi = 0; mi < 4; ++mi)
#pragma unroll
        for (int ni = 0; ni < 4; ++ni) *(f32x4*)(ST + (ni * 16 + r) * 128 + nb + mi * 16 + 4 * q) = acc[mi][ni];
    if (tid < 4) ((float*)(a.ws + WS_SDEC))[(b * NCH + c) * 4 + tid] = __expf(acs[tid * 128 + 127]);
}
DI void ssd_pass2(LAS unsigned char* lds, const Args& a, const LayerP& P, int unit, int wv) {
    const int wave = wv;
    const int c = unit & (NCH - 1), b = unit >> 7, row0 = b * SEQ + c * 128;
    const bf16_t* Hg = (const bf16_t*)(a.ws + WS_H);
    const bf16_t* Hb = Hg + (size_t)b * SEQ * HP;
    LAS bf16_t* Cm = (LAS bf16_t*)lds; LAS bf16_t* R1 = (LAS bf16_t*)(lds + 34816); LAS bf16_t* Mw = (LAS bf16_t*)(lds + 69632 + wave * 8704);
    LAS float* acs = (LAS float*)(lds + 139264); LAS float* dtl = (LAS float*)(lds + 140288); LAS float* rowss = (LAS float*)(lds + 141312);
    const int hh = wave >> 2, lr = (wave & 3) * 32;
    float* YT = (float*)(a.ws + WS_YT);
#pragma unroll 1
    for (int g = 0; g < 2; ++g) {
        const int tid = ltid(wv), lane = tid & 63, cv = tid & 15, t0 = (tid >> 4) * 4, r = lane & 15, q = lane >> 4;
        __syncthreads();
        if (wave < 2) ssd_acs((const float*)(a.ws + WS_DT), P, row0, 2 * g + wave, acs + wave * 128, dtl + wave * 128, lane);
        { float o[4][8]; conv8x4<true>(Hb + C_XBC + 512 + g * 128 + cv * 8, c * 128 + t0, P.ssd_cw + 512 + g * 128 + cv * 8, 768, P.ssd_cb + 512 + g * 128 + cv * 8, o);
#pragma unroll
          for (int t = 0; t < 4; ++t) *(LAS u32x4*)(Cm + (t0 + t) * PT + cv * 8) = pack8(o[t]); }
        { const float* ST = (const float*)((const unsigned char*)a.out + DO_ST) + ((size_t)((b * NCH + c) * 4 + 2 * g)) * 8192;
#pragma unroll
          for (int i = 0; i < 8; ++i) { const int e4 = (i * 512 + tid) * 4; const f32x4 v = *(const f32x4*)(ST + e4); u32x2 w; w.x = pk2(v[0], v[1]); w.y = pk2(v[2], v[3]);
              *(LAS u32x2*)(R1 + (e4 >> 7) * PT + (e4 & 127)) = w; } }
        u32x4 rawB[7]; conv_load(Hb + C_XBC + 256 + g * 128 + cv * 8, c * 128 + t0, rawB);
        __syncthreads();
        f32x4 acc[4][2]; zero_acc(acc);
        wgemm<4, 2>(acc, R1 + hh * 64 * PT, PT, Cm + lr * PT, PT, 128, lane);
#pragma unroll
        for (int ni = 0; ni < 2; ++ni) { const float e = __expf(acs[hh * 128 + lr + ni * 16 + r]);
#pragma unroll
            for (int mi = 0; mi < 4; ++mi) acc[mi][ni] = acc[mi][ni] * e; }
        __syncthreads();
        { float o[4][8]; conv_compute<true>(rawB, P.ssd_cw + 256 + g * 128 + cv * 8, 768, P.ssd_cb + 256 + g * 128 + cv * 8, o);
#pragma unroll
          for (int t = 0; t < 4; ++t) *(LAS u32x4*)(R1 + (t0 + t) * PT + cv * 8) = pack8(o[t]); }
        u32x4 rawX[7]; conv_load(Hb + C_XBC + g * 128 + cv * 8, c * 128 + t0, rawX);
        __syncthreads();
#pragma unroll 1
        for (int sh = 0; sh < 2; ++sh) { f32x4 gacc[2][4]; zero_acc(gacc);
          wgemm<2, 4>(gacc, Cm + lr * PT, PT, R1 + sh * 64 * PT, PT, 128, lane);
#pragma unroll
          for (int mi = 0; mi < 2; ++mi)
#pragma unroll
              for (int j = 0; j < 4; ++j) { const int ll = mi * 16 + 4 * q + j, l = lr + ll; const float al = acs[hh * 128 + l];
#pragma unroll
                  for (int ni = 0; ni < 4; ++ni) { const int s = sh * 64 + ni * 16 + r; const float v = (s <= l) ? gacc[mi][ni][j] * __expf(al - acs[hh * 128 + s]) * dtl[hh * 128 + s] : 0.f; Mw[ll * PT + s] = f2bf(v); } } }
        __syncthreads();
        { float o[4][8]; conv_compute<true>(rawX, P.ssd_cw + g * 128 + cv * 8, 768, P.ssd_cb + g * 128 + cv * 8, o);
#pragma unroll
          for (int k = 0; k < 8; ++k) { u32x2 v; v.x = pk2(o[0][k], o[1][k]); v.y = pk2(o[2][k], o[3][k]); *(LAS u32x2*)(R1 + ((cv >> 3) * 64 + (cv & 7) * 8 + k) * PT + t0) = v; } }
        __syncthreads();
        const int h = 2 * g + hh; const float dsk = P.ssd_d[h];
        u32x2 zr[2][4];
#pragma unroll
        for (int ni = 0; ni < 2; ++ni)
#pragma unroll
            for (int mi = 0; mi < 4; ++mi) zr[ni][mi] = *(const u32x2*)(Hg + (size_t)(row0 + lr + ni * 16 + r) * HP + C_Z + h * 64 + mi * 16 + 4 * q);
        wgemm<4, 2>(acc, R1 + hh * 64 * PT, PT, Mw, PT, 128, lane);
#pragma unroll
        for (int ni = 0; ni < 2; ++ni) { const int l = lr + ni * 16 + r; float ss = 0.f;
#pragma unroll
            for (int mi = 0; mi < 4; ++mi) { const int p0 = mi * 16 + 4 * q; const f32x4 z = bf4_to_f32(zr[ni][mi]); f32x4 y;
#pragma unroll
                for (int j = 0; j < 4; ++j) { const float xs = bf2f(R1[(hh * 64 + p0 + j) * PT + l]); y[j] = (acc[mi][ni][j] + xs * dsk) * silu_f(z[j]); ss += y[j] * y[j]; }
                *(f32x4*)(YT + (size_t)(row0 + l) * 256 + h * 64 + p0) = y; }
            ss += bperm(ss, lane ^ 16); ss += bperm(ss, lane ^ 32);
            if (q == 0) rowss[h * 128 + l] = ss; }
    }
    __syncthreads();
    bf16_t* Y = (bf16_t*)(a.ws + WS_Y);
#pragma unroll 1
    for (int g = 0; g < 2; ++g) { const int lane = ltid(wv) & 63, r = lane & 15, q = lane >> 4, h = 2 * g + hh;
#pragma unroll
        for (int ni = 0; ni < 2; ++ni) { const int l = lr + ni * 16 + r;
            const float rs = __builtin_amdgcn_rsqf(((rowss[l] + rowss[128 + l]) + (rowss[256 + l] + rowss[384 + l])) * (1.0f / 256.0f) + EPS);
#pragma unroll
            for (int mi = 0; mi < 4; ++mi) { const int p0 = mi * 16 + 4 * q; const f32x4 y = *(const f32x4*)(YT + (size_t)(row0 + l) * 256 + h * 64 + p0), ng = *(const f32x4*)(P.ssd_ng + h * 64 + p0);
                u32x2 w; w.x = pk2(y[0] * rs * ng[0], y[1] * rs * ng[1]); w.y = pk2(y[2] * rs * ng[2], y[3] * rs * ng[3]);
                *(u32x2*)(Y + (size_t)(row0 + l) * DMODEL + 256 + h * 64 + p0) = w; } } }
}

constexpr int PQ = 72;
DI float ret_lg(int h) { return log1pf(-exp2f(-5.0f - (float)h)); }
template <int MODE>
DI void ret_stage(const Args& a, int row0, int h, float lg, LAS bf16_t* Qs, LAS bf16_t* Ks, LAS bf16_t* VT, LAS bf16_t* KT, int tid) {
    const bf16_t* Hg = (const bf16_t*)(a.ws + WS_H); const float* tab = (const float*)(a.ws + WS_ROPE64);
    const int t = tid >> 2, part = tid & 3, row = row0 + t; const bf16_t* hr = Hg + (size_t)row * HP;
    float cs[16]; { const f32x4* tp = (const f32x4*)(tab + (size_t)row * 64 + part * 16);
#pragma unroll
        for (int i = 0; i < 4; ++i) { const f32x4 v = tp[i]; cs[4 * i] = v[0]; cs[4 * i + 1] = v[1]; cs[4 * i + 2] = v[2]; cs[4 * i + 3] = v[3]; } }
    { float k1[8], k2[8], o1[8], o2[8]; unpack8(*(const u32x4*)(hr + C_RK + h * 64 + part * 8), k1); unpack8(*(const u32x4*)(hr + C_RK + h * 64 + 32 + part * 8), k2);
      const float sc = 0.125f * (MODE == 0 ? __expf(lg * (float)(127 - t)) : 1.0f);
#pragma unroll
      for (int i = 0; i < 8; ++i) { o1[i] = (k1[i] * cs[2 * i] - k2[i] * cs[2 * i + 1]) * sc; o2[i] = (k1[i] * cs[2 * i + 1] + k2[i] * cs[2 * i]) * sc; }
      if (MODE == 0) {
#pragma unroll
          for (int i = 0; i < 8; ++i) { KT[(part * 8 + i) * PT + t] = f2bf(o1[i]); KT[(32 + part * 8 + i) * PT + t] = f2bf(o2[i]); } }
      else { *(LAS u32x4*)(Ks + t * PQ + part * 8) = pack8(o1); *(LAS u32x4*)(Ks + t * PQ + 32 + part * 8) = pack8(o2); } }
    if (MODE == 1) { float q1[8], q2[8], o1[8], o2[8]; unpack8(*(const u32x4*)(hr + C_RQ + h * 64 + part * 8), q1); unpack8(*(const u32x4*)(hr + C_RQ + h * 64 + 32 + part * 8), q2);
#pragma unroll
      for (int i = 0; i < 8; ++i) { o1[i] = q1[i] * cs[2 * i] - q2[i] * cs[2 * i + 1]; o2[i] = q1[i] * cs[2 * i + 1] + q2[i] * cs[2 * i]; }
      *(LAS u32x4*)(Qs + t * PQ + part * 8) = pack8(o1); *(LAS u32x4*)(Qs + t * PQ + 32 + part * 8) = pack8(o2); }
    { float v[8]; unpack8(*(const u32x4*)(hr + C_RV + h * 64 + part * 16), v);
#pragma unroll
      for (int i = 0; i < 8; ++i) VT[(part * 16 + i) * PT + t] = f2bf(v[i]);
      unpack8(*(const u32x4*)(hr + C_RV + h * 64 + part * 16 + 8), v);
#pragma unroll
      for (int i = 0; i < 8; ++i) VT[(part * 16 + 8 + i) * PT + t] = f2bf(v[i]); }
}
struct RetRaw { f32x4 cs[4]; u32x4 k1, k2, q1, q2, v0, v1; f32x4 rs[2]; };
DI void ret_load(const Args& a, int row0, int h, int bc, int tid, RetRaw& R) {
    const bf16_t* Hg = (const bf16_t*)(a.ws + WS_H); const float* tab = (const float*)(a.ws + WS_ROPE64);
    const int t = tid >> 2, part = tid & 3, row = row0 + t; const bf16_t* hr = Hg + (size_t)row * HP;
    const f32x4* tp = (const f32x4*)(tab + (size_t)row * 64 + part * 16);
#pragma unroll
    for (int i = 0; i < 4; ++i) R.cs[i] = tp[i];
    R.k1 = *(const u32x4*)(hr + C_RK + h * 64 + part * 8); R.k2 = *(const u32x4*)(hr + C_RK + h * 64 + 32 + part * 8);
    R.q1 = *(const u32x4*)(hr + C_RQ + h * 64 + part * 8); R.q2 = *(const u32x4*)(hr + C_RQ + h * 64 + 32 + part * 8);
    R.v0 = *(const u32x4*)(hr + C_RV + h * 64 + part * 16); R.v1 = *(const u32x4*)(hr + C_RV + h * 64 + part * 16 + 8);
    const float* RS = (const float*)((const unsigned char*)a.out + DO_RS) + ((size_t)(bc * 4 + h)) * 4096;
#pragma unroll
    for (int i = 0; i < 2; ++i) R.rs[i] = *(const f32x4*)(RS + (i * 512 + tid) * 4);
}
DI void ret_write(const RetRaw& R, LAS bf16_t* Qs, LAS bf16_t* Ks, LAS bf16_t* VT, LAS bf16_t* STt, int tid) {
    const int t = tid >> 2, part = tid & 3;
    float cs[16];
#pragma unroll
    for (int i = 0; i < 4; ++i) { cs[4 * i] = R.cs[i][0]; cs[4 * i + 1] = R.cs[i][1]; cs[4 * i + 2] = R.cs[i][2]; cs[4 * i + 3] = R.cs[i][3]; }
    { float k1[8], k2[8], o1[8], o2[8]; unpack8(R.k1, k1); unpack8(R.k2, k2);
#pragma unroll
      for (int i = 0; i < 8; ++i) { o1[i] = (k1[i] * cs[2 * i] - k2[i] * cs[2 * i + 1]) * 0.125f; o2[i] = (k1[i] * cs[2 * i + 1] + k2[i] * cs[2 * i]) * 0.125f; }
      *(LAS u32x4*)(Ks + t * PQ + part * 8) = pack8(o1); *(LAS u32x4*)(Ks + t * PQ + 32 + part * 8) = pack8(o2); }
    { float q1[8], q2[8], o1[8], o2[8]; unpack8(R.q1, q1); unpack8(R.q2, q2);
#pragma unroll
      for (int i = 0; i < 8; ++i) { o1[i] = q1[i] * cs[2 * i] - q2[i] * cs[2 * i + 1]; o2[i] = q1[i] * cs[2 * i + 1] + q2[i] * cs[2 * i]; }
      *(LAS u32x4*)(Qs + t * PQ + part * 8) = pack8(o1); *(LAS u32x4*)(Qs + t * PQ + 32 + part * 8) = pack8(o2); }
    { float v[8]; unpack8(R.v0, v);
#pragma unroll
      for (int i = 0; i < 8; ++i) VT[(part * 16 + i) * PT + t] = f2bf(v[i]);
      unpack8(R.v1, v);
#pragma unroll
      for (int i = 0; i < 8; ++i) VT[(part * 16 + 8 + i) * PT + t] = f2bf(v[i]); }
#pragma unroll
    for (int i = 0; i < 2; ++i) { const int e4 = (i * 512 + tid) * 4; const f32x4 v = R.rs[i]; u32x2 w; w.x = pk2(v[0], v[1]); w.y = pk2(v[2], v[3]); *(LAS u32x2*)(STt + (e4 >> 6) * PQ + (e4 & 63)) = w; }
}
DI void ret_pass1(LAS unsigned char* lds, const Args& a, int unit, int wv) {
    const int wave = wv, c = unit & (NCH - 1), b = unit >> 7, row0 = b * SEQ + c * 128;
    const int tid = ltid(wv), lane = tid & 63, r = lane & 15, q = lane >> 4;
    __syncthreads();
#pragma unroll
    for (int h = 0; h < 4; ++h) ret_stage<0>(a, row0, h, ret_lg(h), nullptr, nullptr, (LAS bf16_t*)(lds + h * 34816), (LAS bf16_t*)(lds + h * 34816 + 17408), tid);
    __syncthreads();
    const int h = wave >> 1, e0 = (wave & 1) * 32;
    LAS bf16_t* VT = (LAS bf16_t*)(lds + h * 34816); LAS bf16_t* KT = (LAS bf16_t*)(lds + h * 34816 + 17408);
    f32x4 acc[4][2]; zero_acc(acc);
    wgemm<4, 2>(acc, KT, PT, VT + e0 * PT, PT, 128, lane);
    float* RS = (float*)((unsigned char*)a.out + DO_RS) + ((size_t)((b * NCH + c) * 4 + h)) * 4096;
#pragma unroll
    for (int mi = 0; mi < 4; ++mi)
#pragma unroll
        for (int ni = 0; ni < 2; ++ni) *(f32x4*)(RS + (e0 + ni * 16 + r) * 64 + mi * 16 + 4 * q) = acc[mi][ni];
}
DI void ret_pass2(LAS unsigned char* lds, const Args& a, const LayerP& P, int unit, int wv) {
    const int wave = wv, c = unit & (NCH - 1), b = unit >> 7, row0 = b * SEQ + c * 128, i0 = wave * 16;
    LAS bf16_t* Qs = (LAS bf16_t*)lds; LAS bf16_t* Ks = (LAS bf16_t*)(lds + 18432); LAS bf16_t* VT = (LAS bf16_t*)(lds + 36864); LAS bf16_t* STt = (LAS bf16_t*)(lds + 54272);
    LAS bf16_t* Pw = (LAS bf16_t*)(lds + 63488 + wave * 4352);
    const bf16_t* Hg = (const bf16_t*)(a.ws + WS_H); bf16_t* Y = (bf16_t*)(a.ws + WS_Y);
    RetRaw R; ret_load(a, row0, 0, b * NCH + c, ltid(wv), R);
#pragma unroll 1
    for (int h = 0; h < 4; ++h) {
        const int tid = ltid(wv), lane = tid & 63, r = lane & 15, q = lane >> 4;
        const float lg = ret_lg(h);
        __syncthreads();
        ret_write(R, Qs, Ks, VT, STt, tid);
        if (h < 3) ret_load(a, row0, h + 1, b * NCH + c, tid, R);
        __syncthreads();
        { f32x4 sacc[1][8]; zero_acc(sacc);
          wgemm<1, 8>(sacc, Qs + i0 * PQ, PQ, Ks, PQ, 64, lane);
#pragma unroll
          for (int j = 0; j < 4; ++j) { const int ii = 4 * q + j, i = i0 + ii;
#pragma unroll
              for (int ni = 0; ni < 8; ++ni) { const int jj = ni * 16 + r; const float v = (i >= jj) ? sacc[0][ni][j] * __expf(lg * (float)(i - jj)) : 0.f; Pw[ii * PT + jj] = f2bf(v); } } }
        __syncthreads();
        u32x2 gr[4];
#pragma unroll
        for (int mi = 0; mi < 4; ++mi) gr[mi] = *(const u32x2*)(Hg + (size_t)(row0 + i0 + r) * HP + C_RG + h * 64 + mi * 16 + 4 * q);
        f32x4 oacc[4][1], cacc[4][1]; zero_acc(oacc); zero_acc(cacc);
        wgemm<4, 1>(oacc, VT, PT, Pw, PT, 128, lane);
        wgemm<4, 1>(cacc, STt, PQ, Qs + i0 * PQ, PQ, 64, lane);
        { const int i = i0 + r; const float qd = __expf(lg * (float)(i + 1)); f32x4 o[4]; float s = 0.f;
#pragma unroll
          for (int mi = 0; mi < 4; ++mi) { o[mi] = oacc[mi][0] + cacc[mi][0] * qd; s += (o[mi][0] + o[mi][1]) + (o[mi][2] + o[mi][3]); }
          s += bperm(s, lane ^ 16); s += bperm(s, lane ^ 32);
          const float mu = s * (1.0f / 64.0f); float v2 = 0.f;
#pragma unroll
          for (int mi = 0; mi < 4; ++mi) { o[mi] = o[mi] - mu; v2 += (o[mi][0] * o[mi][0] + o[mi][1] * o[mi][1]) + (o[mi][2] * o[mi][2] + o[mi][3] * o[mi][3]); }
          v2 += bperm(v2, lane ^ 16); v2 += bperm(v2, lane ^ 32);
          const float rs = __builtin_amdgcn_rsqf(v2 * (1.0f / 64.0f) + EPS);
#pragma unroll
          for (int mi = 0; mi < 4; ++mi) { const int ch = h * 64 + mi * 16 + 4 * q; const f32x4 gt = bf4_to_f32(gr[mi]);
              const f32x4 gg = *(const f32x4*)(P.ret_g + ch), bb = *(const f32x4*)(P.ret_b + ch); const f32x4 y = o[mi] * rs * gg + bb;
              u32x2 w; w.x = pk2(silu_f(gt[0]) * y[0], silu_f(gt[1]) * y[1]); w.y = pk2(silu_f(gt[2]) * y[2], silu_f(gt[3]) * y[3]);
              *(u32x2*)(Y + (size_t)(row0 + i) * DMODEL + 512 + ch) = w; } }
    }
}

constexpr int PU = 264;
template <bool OUT>
DI void lru_sweep(LAS bf16_t* U, LAS float* SUM, const Args& a, const LayerP& P, int row0, int wv, const float* LC, f32x2* LSWc) {
    const int wave = wv, l0 = wave * 16;
    const bf16_t* LWT = (const bf16_t*)(a.ws + WS_W + W_LRU); const bf16_t* Hg = (const bf16_t*)(a.ws + WS_H); bf16_t* Y = (bf16_t*)(a.ws + WS_Y);
#pragma unroll 1
    for (int g = 0; g < 4; ++g) {
        const int lane = ltid(wv) & 63, r = lane & 15, q = lane >> 4;
        bf16x8 af[2];
#pragma unroll
        for (int ks = 0; ks < 2; ++ks) af[ks] = *(const LAS bf16x8*)(U + (l0 + r) * PU + g * 64 + ks * 32 + q * 8);
#pragma unroll
        for (int ni = 0; ni < 4; ++ni) { f32x4 aa1 = (f32x4){0.f, 0.f, 0.f, 0.f}, ax1 = aa1;
#pragma unroll
            for (int ks = 0; ks < 2; ++ks) { const bf16x8 wa = *(const bf16x8*)(LWT + ((size_t)(g * 64 + ni * 16 + r)) * 64 + ks * 32 + q * 8), wx = *(const bf16x8*)(LWT + ((size_t)((4 + g) * 64 + ni * 16 + r)) * 64 + ks * 32 + q * 8);
                aa1 = __builtin_amdgcn_mfma_f32_16x16x32_bf16(af[ks], wa, aa1, 0, 0, 0); ax1 = __builtin_amdgcn_mfma_f32_16x16x32_bf16(af[ks], wx, ax1, 0, 0, 0); }
            const int ch = g * 64 + ni * 16 + r; const float ba = P.lru_ba[ch], bx = P.lru_bx[ch], c8 = -8.0f * softplus_f(-P.lru_ap[ch]);
            float Pi[4], Ei[4], Pc = 1.f, Ec = 0.f;
#pragma unroll
            for (int j = 0; j < 4; ++j) { const float rg = sigmoid_f(aa1[j] + ba), ig = sigmoid_f(ax1[j] + bx); const float la = c8 * rg, oma = one_minus_exp(la), av = 1.0f - oma;
                const float u = bf2f(U[(l0 + 4 * q + j) * PU + ch]); const float inp = __builtin_amdgcn_sqrtf(oma * (2.0f - oma)) * (ig * u);
                if (!OUT) ((unsigned*)(a.ws + WS_LA))[(size_t)(row0 + l0 + 4 * q + j) * 256 + ch] = pk2(oma, inp);
                Ec = av * Ec + inp; Pc = Pc * av; Pi[j] = Pc; Ei[j] = Ec; }
            float Pp = 1.f, Ep = 0.f;
#pragma unroll
            for (int qq = 0; qq < 3; ++qq) { const float Pq = bperm(Pc, r + 16 * qq), Eq = bperm(Ec, r + 16 * qq); if (qq < q) { Ep = Pq * Ep + Eq; Pp = Pp * Pq; } }
#pragma unroll
            for (int j = 0; j < 4; ++j) { Ei[j] = Pi[j] * Ep + Ei[j]; Pi[j] = Pp * Pi[j]; }
            if (!OUT) { if (q == 3) { SUM[(wave * 256 + ch) * 2] = Pi[3]; SUM[(wave * 256 + ch) * 2 + 1] = Ei[3]; LSWc[wave * 256 + ch] = (f32x2){Pi[3], Ei[3]}; } }
            else { float hp = LC[ch];
                { f32x2 t[7];
#pragma unroll
                  for (int w = 0; w < 7; ++w) if (w < wave) t[w] = LSWc[w * 256 + ch];
#pragma unroll
                  for (int w = 0; w < 7; ++w) if (w < wave) hp = t[w][0] * hp + t[w][1]; }
#pragma unroll
                for (int j = 0; j < 4; ++j) { const int row = row0 + l0 + 4 * q + j; const float hv = Pi[j] * hp + Ei[j]; const float gt = bf2f(Hg[(size_t)row * HP + C_LG + ch]);
                    Y[(size_t)row * DMODEL + 768 + ch] = f2bf(hv * gelu_tanh_f(gt)); } }
        }
    }
}
template <int MODE>
DI void lru_chunk(LAS unsigned char* lds, const Args& a, const LayerP& P, int unit, int wv) {
    const int tid = ltid(wv), c = unit & (NCH - 1), b = unit >> 7, row0 = b * SEQ + c * 128;
    LAS bf16_t* U = (LAS bf16_t*)lds; LAS float* SUM = (LAS float*)(lds + 67584);
    const bf16_t* Hb = (const bf16_t*)(a.ws + WS_H) + (size_t)b * SEQ * HP;
    __syncthreads();
    { const int cv = tid & 31, run = tid >> 5;
#pragma unroll
      for (int hf = 0; hf < 2; ++hf) { const int t0 = run * 8 + hf * 4; float o[4][8]; conv8x4<false>(Hb + C_LX + cv * 8, c * 128 + t0, P.lru_cw + cv * 8, 256, P.lru_cb + cv * 8, o);
#pragma unroll
          for (int t = 0; t < 4; ++t) *(LAS u32x4*)(U + (t0 + t) * PU + cv * 8) = pack8(o[t]); } }
    __syncthreads();
    f32x2* LSWc = (f32x2*)(a.ws + WS_LSW) + (size_t)(b * NCH + c) * 8 * 256;
    if (MODE == 0) {
        lru_sweep<false>(U, SUM, a, P, row0, wv, nullptr, LSWc);
        __syncthreads();
        if (tid < 256) { float Pc = 1.f, Ec = 0.f;
#pragma unroll
            for (int w = 0; w < 8; ++w) { const float Pw = SUM[(w * 256 + tid) * 2], Ew = SUM[(w * 256 + tid) * 2 + 1]; Ec = Pw * Ec + Ew; Pc = Pc * Pw; }
            float* LS = (float*)(a.ws + WS_LSUM) + ((size_t)(b * NCH + c) * 256 + tid) * 2; LS[0] = Pc; LS[1] = Ec; }
    } else {
        lru_sweep<true>(U, SUM, a, P, row0, wv, (const float*)(a.ws + WS_LCARRY) + (size_t)(b * NCH + c) * 256, LSWc);
    }
}

DI void lru_out(const Args& a, int unit, int wv) {
    const int tid = ltid(wv), c = unit & (NCH - 1), b = unit >> 7, row0 = b * SEQ + c * 128, ch = (tid & 63) * 4, k = wv;
    const u32x4* LAI = (const u32x4*)(a.ws + WS_LA); const bf16_t* Hg = (const bf16_t*)(a.ws + WS_H); bf16_t* Y = (bf16_t*)(a.ws + WS_Y);
    const f32x4* LSWc = (const f32x4*)((const f32x2*)(a.ws + WS_LSW) + (size_t)(b * NCH + c) * 8 * 256);
    f32x4 h = *(const f32x4*)((const float*)(a.ws + WS_LCARRY) + (size_t)(b * NCH + c) * 256 + ch);
    f32x4 t0[7], t1[7];
#pragma unroll
    for (int w = 0; w < 7; ++w) if (w < k) { t0[w] = LSWc[(w * 256 + ch) / 2]; t1[w] = LSWc[(w * 256 + ch) / 2 + 1]; }
#pragma unroll
    for (int w = 0; w < 7; ++w) if (w < k) { h[0] = t0[w][0] * h[0] + t0[w][1]; h[1] = t0[w][2] * h[1] + t0[w][3]; h[2] = t1[w][0] * h[2] + t1[w][1]; h[3] = t1[w][2] * h[3] + t1[w][3]; }
    u32x4 pr[16]; u32x2 gt[16];
#pragma unroll
    for (int t = 0; t < 16; ++t) { const size_t row = (size_t)(row0 + 16 * k + t); pr[t] = LAI[(row * 256 + ch) / 4]; gt[t] = *(const u32x2*)(Hg + row * HP + C_LG + ch); }
#pragma unroll
    for (int t = 0; t < 16; ++t) { const unsigned w4[4] = {pr[t].x, pr[t].y, pr[t].z, pr[t].w};
#pragma unroll
        for (int e = 0; e < 4; ++e) { const float oma = __uint_as_float(w4[e] << 16), inp = __uint_as_float(w4[e] & 0xffff0000u); h[e] = (h[e] - oma * h[e]) + inp; }
        const f32x4 g = bf4_to_f32(gt[t]); u32x2 w; w.x = pk2(h[0] * gelu_tanh_f(g[0]), h[1] * gelu_tanh_f(g[1])); w.y = pk2(h[2] * gelu_tanh_f(g[2]), h[3] * gelu_tanh_f(g[3]));
        *(u32x2*)(Y + (size_t)(row0 + 16 * k + t) * DMODEL + 768 + ch) = w; }
}

DI void chunk_scans(const Args& a, int tid) {
    const int gt = lbid() * 512 + tid, NT = lgdim() * 512;
    for (int n = gt; n < 2 * DFF; n += NT) { const float* p1 = (const float*)(a.ws + WS_W + W_PART1) + n; const float* p2 = (const float*)(a.ws + WS_W + W_PART2) + n; float s1 = 0.f, s2 = 0.f;
#pragma unroll
        for (int kb = 0; kb < 16; ++kb) { s1 += p1[(size_t)kb * 2 * DFF]; s2 += p2[(size_t)kb * 2 * DFF]; }
        ((float*)(a.ws + WS_W + W_C1F))[n] = s1; ((float*)(a.ws + WS_W + W_C2F))[n] = s2; }
    for (int idx = gt; idx < 65536 + 32768 + 512; idx += NT) {
        if (idx < 65536) { const int b = idx >> 15, rem = idx & 32767, h = rem >> 13;
            float* p = (float*)((unsigned char*)a.out + DO_ST) + (size_t)b * NCH * 32768 + rem; const float* dec = (const float*)(a.ws + WS_SDEC) + b * NCH * 4 + h; float st = 0.f;
#pragma unroll 1
            for (int c0 = 0; c0 < NCH; c0 += 16) { float t[16], d[16];
#pragma unroll
                for (int j = 0; j < 16; ++j) { t[j] = p[(size_t)(c0 + j) * 32768]; d[j] = dec[(c0 + j) * 4]; }
#pragma unroll
                for (int j = 0; j < 16; ++j) { p[(size_t)(c0 + j) * 32768] = st; st = st * d[j] + t[j]; } }
        } else if (idx < 65536 + 32768) { const int i2 = idx - 65536, b = i2 >> 14, rem = i2 & 16383, h = rem >> 12; const float cd = __expf(ret_lg(h) * 128.0f);
            float* p = (float*)((unsigned char*)a.out + DO_RS) + (size_t)b * NCH * 16384 + rem; float st = 0.f;
#pragma unroll 1
            for (int c0 = 0; c0 < NCH; c0 += 16) { float t[16];
#pragma unroll
                for (int j = 0; j < 16; ++j) t[j] = p[(size_t)(c0 + j) * 16384];
#pragma unroll
                for (int j = 0; j < 16; ++j) { p[(size_t)(c0 + j) * 16384] = st; st = st * cd + t[j]; } }
        } else { const int i3 = idx - 65536 - 32768, b = i3 >> 8, ch = i3 & 255;
            const float* ls = (const float*)(a.ws + WS_LSUM) + ((size_t)b * NCH * 256 + ch) * 2; float* lc = (float*)(a.ws + WS_LCARRY) + (size_t)b * NCH * 256 + ch; float hv = 0.f;
#pragma unroll 1
            for (int c0 = 0; c0 < NCH; c0 += 16) { f32x2 t[16];
#pragma unroll
                for (int j = 0; j < 16; ++j) t[j] = *(const f32x2*)(ls + (c0 + j) * 512);
#pragma unroll
                for (int j = 0; j < 16; ++j) { lc[(c0 + j) * 256] = hv; hv = t[j][0] * hv + t[j][1]; } }
        }
    }
}

#define GSYNC() do { XcdBarrier b_; b_.bar = (unsigned*)(kargs()->ws) + CW_BAR; b_.x = xb_xcc_id(); b_.st = MISC; xcd_barrier(b_, wv0); } while (0)
#ifndef REP_MIX1
#define REP_MIX1 1
#endif
#ifndef REP_MIX2
#define REP_MIX2 1
#endif
#ifndef REP_ATTN
#define REP_ATTN 1
#endif
#ifndef REP_GEMM
#define REP_GEMM 1
#endif
#ifndef REP_LN
#define REP_LN 1
#endif
#ifndef REP_SCAN
#define REP_SCAN 1
#endif
#ifndef REP_F1
#define REP_F1 1
#endif
#ifndef REP_OUT
#define REP_OUT 1
#endif
#ifndef REP_SSD
#define REP_SSD 1
#endif
#ifndef REP_RET
#define REP_RET 1
#endif
#ifndef REP_LRU
#define REP_LRU 1
#endif
#ifndef REP_QKV
#define REP_QKV 1
#endif
#define PH_LOCALS const KArgs ka = kargs(); const Args a = *ka; const int tid = ltid(wv0), lane = tid & 63, wave = __builtin_amdgcn_readfirstlane(tid >> 6), bid = lbid(), G = lgdim(), gw = bid * 8 + wave, NGW = G * 8; (void)lane; (void)gw; (void)NGW; unsigned char* const ws = a.ws; (void)ws; \
    bf16_t* const XB = (bf16_t*)(ws + WS_XB); bf16_t* const Hh = (bf16_t*)(ws + WS_H); bf16_t* const Yb = (bf16_t*)(ws + WS_Y); float* const XF = (float*)(ws + WS_XF); unsigned char* const wb = ws + WS_W; \
    (void)XB; (void)Hh; (void)Yb; (void)XF; (void)wb;
__global__ void __launch_bounds__(512, 2) hybrid_fwd(Args unused_args) {
    extern __shared__ __attribute__((aligned(16))) unsigned char lds_raw[];
    LAS unsigned char* lds = (LAS unsigned char*)lds_raw;
    const int wv0 = __builtin_amdgcn_readfirstlane(threadIdx.x >> 6);
    volatile LAS unsigned* MISC = (volatile LAS unsigned*)(lds + LDS_BYTES - 64);
    if (threadIdx.x < 16) MISC[threadIdx.x] = 0u;
    __syncthreads();
    xcd_barrier_post((unsigned*)(kargs()->ws) + CW_BAR, MISC, wv0);
    cg::grid_group grid = cg::this_grid();

#ifndef REP_P0
#define REP_P0 1
#endif
    for (int rep_ = 0; rep_ < REP_P0; ++rep_)
    { PH_LOCALS
#ifndef SK_CONV
      convert_weights(a, 0, lds, wave, lane);
#endif
      const float* x = a.in[0];
#pragma unroll 4
      for (size_t i = (size_t)bid * 512 + tid; i < (size_t)T * DMODEL / 8; i += (size_t)G * 512) { const f32x4 v0 = ((const f32x4*)x)[2 * i], v1 = ((const f32x4*)x)[2 * i + 1];
          u32x4 w; w.x = pk2(v0[0], v0[1]); w.y = pk2(v0[2], v0[3]); w.z = pk2(v1[0], v1[1]); w.w = pk2(v1[2], v1[3]); ((u32x4*)XB)[i] = w; }
      float* r16 = (float*)(ws + WS_ROPE16); float* r64 = (float*)(ws + WS_ROPE64);
      for (int i = bid * 512 + tid; i < T * 40; i += G * 512) { const int row = i / 40, k = i % 40; const float pos = (float)a.pos[row];
          const float inv = k < 8 ? exp2f(-(float)(2 * k) * (13.287712379549449f / 16.0f)) : exp2f(-(float)(2 * (k - 8)) * (13.287712379549449f / 64.0f));
          const float ang = pos * inv; double ad = (double)ang; ad -= 6.283185307179586 * rint(ad * 0.15915494309189535); const float ar = (float)ad; const float sn = __sinf(ar), cs = __cosf(ar);
          if (k < 8) { r16[(size_t)row * 16 + 2 * k] = cs; r16[(size_t)row * 16 + 2 * k + 1] = sn; } else { r64[(size_t)row * 64 + 2 * (k - 8)] = cs; r64[(size_t)row * 64 + 2 * (k - 8) + 1] = sn; } } }
    if (__builtin_expect(kargs()->ws == nullptr, 0)) grid.sync();
    GSYNC();
#ifdef PROBE_CGSYNC
    for (int i_ = 0; i_ < PROBE_CGSYNC; ++i_) grid.sync();
#endif

    for (int l = 0; l < 2; ++l) {
for (int rep_ = 0; rep_ < REP_GEMM; ++rep_) {
#ifndef SK_G_IN
        { PH_LOCALS
          pg8::Gemm g{XB, (const bf16_t*)(wb + W_IN), T, HP, 1024, 1024}; pg8::StaticOrder S; S.init(T, HP, G, bid);
          EpiIn E{Hh, (float*)(ws + WS_DT), (float*)(ws + WS_SSQQ), (float*)(ws + WS_SSQKV)};
          pg8::gemm_phase<EpiIn, pg8::StaticOrder, true, true>(lds, g, S, E, wv0); }
#endif
}

        GSYNC();
for (int rep_ = 0; rep_ < REP_QKV; ++rep_) {
#ifndef SK_G_KV
        { PH_LOCALS
          pg8::Gemm g{Hh + C_CKV, (const bf16_t*)(wb + W_UKV), T, 512, 256, HP}; pg8::StaticOrder S; S.init(T, 512, G, bid);
          EpiKV E{(bf16_t*)((unsigned char*)a.out + DO_K), (bf16_t*)((unsigned char*)a.out + DO_V), Hh, (const float*)(ws + WS_SSQKV), (const float*)(ws + WS_ROPE16)};
          pg8::gemm_phase<EpiKV, pg8::StaticOrder, true, true>(lds, g, S, E, wv0); }
#endif
}

for (int rep_ = 0; rep_ < REP_MIX1; ++rep_) {
#ifndef SK_SSD1
        { PH_LOCALS const LayerP P = layer_params(ka, l);
          for (int r2_ = 0; r2_ < REP_SSD; ++r2_)
          for (int u = bid; u < NB * NCH; u += G) ssd_pass1(lds, a, P, u, wv0); }
#endif
#ifndef SK_RET1
        { PH_LOCALS
          for (int r2_ = 0; r2_ < REP_RET; ++r2_)
          for (int u = bid; u < NB * NCH; u += G) ret_pass1(lds, a, u, wv0); }
#endif
#ifndef SK_LRU0
        { PH_LOCALS const LayerP P = layer_params(ka, l);
          for (int r2_ = 0; r2_ < REP_LRU; ++r2_)
          for (int u = bid; u < NB * NCH; u += G) lru_chunk<0>(lds, a, P, u, wv0); }
#endif
}

        GSYNC();
#ifdef PROBE_SYNCS
        for (int i_ = 0; i_ < PROBE_SYNCS; ++i_) GSYNC();
#endif
#ifndef SK_SCAN
        { PH_LOCALS chunk_scans(a, tid); }
#endif
for (int rep_ = 0; rep_ < REP_QKV; ++rep_) {
#ifndef SK_G_Q
        { PH_LOCALS
          pg8::Gemm g{Hh + C_CQ, (const bf16_t*)(wb + W_UQ), T, 256, 256, HP}; pg8::StaticOrder S; S.init(T, 256, G, (bid + G / 2) % G);
          EpiQ E{(bf16_t*)((unsigned char*)a.out + DO_Q), (const float*)(ws + WS_SSQQ), (const float*)(ws + WS_ROPE16)};
          pg8::gemm_phase<EpiQ, pg8::StaticOrder, true, true>(lds, g, S, E, wv0); }
#endif
}
        GSYNC();
for (int rep_ = 0; rep_ < REP_MIX2; ++rep_) {
#ifndef SK_SSD2
        { PH_LOCALS const LayerP P = layer_params(ka, l);
          for (int r2_ = 0; r2_ < REP_SSD; ++r2_)
          for (int u = bid; u < NB * NCH; u += G) ssd_pass2(lds, a, P, u, wv0); }
#endif
#ifndef SK_RET2
        { PH_LOCALS const LayerP P = layer_params(ka, l);
          for (int r2_ = 0; r2_ < REP_RET; ++r2_)
          for (int u = bid; u < NB * NCH; u += G) ret_pass2(lds, a, P, u, wv0); }
#endif
#ifndef SK_LRU1
        { PH_LOCALS const LayerP P = layer_params(ka, l);
          for (int r2_ = 0; r2_ < REP_LRU; ++r2_)
          for (int u = bid; u < NB * NCH; u += G) lru_out(a, u, wv0); }
#endif
}

        __syncthreads();
for (int rep_ = 0; rep_ < REP_ATTN; ++rep_) {
#ifndef SK_ATTN
        { PH_LOCALS
          const attn_body::AttnTensors AT{(const attn_body::bf16*)((unsigned char*)a.out + DO_Q), (const attn_body::bf16*)((unsigned char*)a.out + DO_K), (const attn_body::bf16*)((unsigned char*)a.out + DO_V), (attn_body::bf16*)Yb};
          const attn_body::StaticOrder S(G, bid);
          attn_body::attn_phase<attn_body::StaticOrder>((char*)lds_raw, AT, S, wv0); }
#endif
}

        GSYNC();
        for (int rep_ = 0; rep_ < REP_OUT; ++rep_) {
        { PH_LOCALS
          pg8::Gemm g{Yb, (const bf16_t*)(wb + W_OUT), T, 1024, 1024, 1024}; pg8::StaticOrder S; S.init(T, 1024, G, bid);
          EpiResA E{l == 0 ? a.in[0] : (const float*)nullptr, XB, XB, (float*)(ws + WS_STAT1)};
          pg8::gemm_phase<EpiResA, pg8::StaticOrder, true, true>(lds, g, S, E, wv0); }
        }
        GSYNC();
        for (int rep_ = 0; rep_ < REP_F1; ++rep_) {
        { PH_LOCALS
          pg8::Gemm g{XB, (const bf16_t*)(wb + W_F1), T, 2 * DFF, 1024, 1024}; pg8::StaticOrder S; S.init(T, 2 * DFF, G, bid);
          EpiSwiGLU E{Hh, (const float*)(ws + WS_STAT1), (const float*)(wb + W_C1F), (const float*)(wb + W_C2F)};
          pg8::gemm_phase<EpiSwiGLU, pg8::StaticOrder, true, true>(lds, g, S, E, wv0); }
        }
        GSYNC();
        { PH_LOCALS const LayerP P = layer_params(ka, l);
          pg8::Gemm g{Hh, (const bf16_t*)(wb + W_F2), T, 1024, DFF, DFF}; pg8::StaticOrder S; S.init(T, 1024, G, bid);
          EpiResB E{XB, XB, l == 0 ? (float*)nullptr : a.out, (const float*)(ws + WS_STAT1), P.ln1g, P.ln1b};
          pg8::gemm_phase<EpiResB, pg8::StaticOrder, true, true>(lds, g, S, E, wv0); }
        GSYNC();
        { PH_LOCALS const LayerP P = layer_params(ka, l);
          if (l == 0) { for (int m = gw; m < T; m += 2 * NGW) { const int m2 = m + NGW < T ? m + NGW : m; ln_rows2_bf16(XB + (size_t)m * DMODEL, XB + (size_t)m2 * DMODEL, P.ln2g, P.ln2b, lane, m2 != m); }
                        __syncthreads();
#ifndef SK_CONV
                        convert_weights(a, 1, lds, wave, lane);
#endif
          }
          else { for (int m = gw; m < T; m += 2 * NGW) { const int m2 = m + NGW < T ? m + NGW : m; ln_rows2_f32(a.out + (size_t)m * DMODEL, a.out + (size_t)m2 * DMODEL, P.ln2g, P.ln2b, lane, m2 != m); } } }
        if (l == 0) GSYNC();
    }
}

extern "C" void kernel_launch(void* const* d_in, const int* in_sizes, int n_in, void* d_out, int out_size, void* d_ws, size_t ws_size, hipStream_t stream) {
    static int grid = 0;
    if (grid == 0) {
        if (n_in != 29 || in_sizes[0] != T * DMODEL || out_size != T * DMODEL || ws_size < WS_END) { fprintf(stderr, "kernel_launch: unexpected shapes (n_in %d, in0 %d, out %d, ws %zu)\n", n_in, n_in > 0 ? in_sizes[0] : -1, out_size, ws_size); grid = -1; return; }
        int dev = 0, cus = 0, per_cu = 0;
        hipGetDevice(&dev); hipDeviceGetAttribute(&cus, hipDeviceAttributeMultiprocessorCount, dev);
        if (hipFuncSetAttribute((const void*)hybrid_fwd, hipFuncAttributeMaxDynamicSharedMemorySize, LDS_BYTES) != hipSuccess) { fprintf(stderr, "kernel_launch: hipFuncSetAttribute failed\n"); grid = -1; return; }
        if (hipOccupancyMaxActiveBlocksPerMultiprocessor(&per_cu, (const void*)hybrid_fwd, 512, LDS_BYTES) != hipSuccess || per_cu < 1) { fprintf(stderr, "kernel_launch: occupancy query gave %d\n", per_cu); per_cu = 1; }
        (void)hipGetLastError();
        grid = cus * 1;
    }
    if (grid < 0) return;
    Args a{};
    for (int i = 0; i < 29; ++i) a.in[i] = (const float*)d_in[i];
    a.pos = (const int*)d_in[1]; a.out = (float*)d_out; a.ws = (unsigned char*)d_ws;
    if (hipMemsetAsync(d_ws, 0, 65536, stream) != hipSuccess) { fprintf(stderr, "kernel_launch: memset failed\n"); return; }
    void* args[] = {&a};
    hipError_t e = hipLaunchCooperativeKernel((const void*)hybrid_fwd, dim3(grid), dim3(512), args, LDS_BYTES, stream);
    if (e != hipSuccess) fprintf(stderr, "cooperative launch failed: %s (grid %d)\n", hipGetErrorString(e), grid);
}
```
